# Optimizing an MI355X kernel written in HIP

```python
import math
import jax
import jax.numpy as jnp
from jax import lax
import numpy as np

D_MODEL = 2048
BATCH = 2
SEQ = 8192
DEPTH = 1

N_META = 16
HEAD_DIM = 64
ATTN_WIDTH = D_MODEL // 2
N_Q_HEADS = ATTN_WIDTH // HEAD_DIM
N_KV_HEADS = 4
Q_PER_KV = N_Q_HEADS // N_KV_HEADS
KV_WIDTH = N_KV_HEADS * HEAD_DIM
WINDOW = 128
ATTN_BLOCK = 128
ROPE_THETA = 10000.0
SSM_WIDTH = D_MODEL - ATTN_WIDTH
SSM_GROUP = 16
N_SSM_GROUPS = SSM_WIDTH // SSM_GROUP
SSM_STATE = 64
MIX_WIDTH = ATTN_WIDTH + SSM_WIDTH
IN_WIDTH = ATTN_WIDTH + 2 * KV_WIDTH + SSM_WIDTH
N_EXPERTS = 32
TOP_K = 4
D_FF = D_MODEL
SWIGLU_LIMIT = 7.0
SWIGLU_ALPHA = 1.702
MOE_ROW_BLOCK = 256
NORM_EPS = 1e-5
DT_MIN = 1e-3
DT_MAX = 1e-1
C_INIT_SCALE = 0.5

kernel_name = "hymba_swa_sink_s5_moe_layer"


def rms_norm(t, gain):
    t32 = t.astype(jnp.float32)
    y = t32 * lax.rsqrt(jnp.mean(t32 * t32, axis=-1, keepdims=True) + NORM_EPS)
    return (y * gain.astype(jnp.float32)).astype(t.dtype)


def rope(t, positions):
    half = HEAD_DIM // 2
    inv_freq = jnp.power(ROPE_THETA, -jnp.arange(half, dtype=jnp.float32) / half)
    ang = positions.astype(jnp.float32)[:, None] * inv_freq[None, :]
    cos = jnp.cos(ang)[None, :, None, :]
    sin = jnp.sin(ang)[None, :, None, :]
    t32 = t.astype(jnp.float32)
    t1, t2 = t32[..., :half], t32[..., half:]
    return jnp.concatenate([t1 * cos - t2 * sin, t2 * cos + t1 * sin], axis=-1).astype(t.dtype)


def sink_softmax(scores, mask, sink):
    scores = jnp.where(mask, scores, jnp.finfo(jnp.float32).min)
    sink_col = jnp.broadcast_to(sink[:, :, None, None], scores.shape[:-1] + (1,))
    p = jax.nn.softmax(jnp.concatenate([scores, sink_col], axis=-1), axis=-1)
    return p[..., :-1]


def sliding_window_attention(q, k, v, sinks):
    bsz, L = q.shape[0], q.shape[1]
    S = L - N_META
    nb = S // ATTN_BLOCK
    scale = HEAD_DIM ** -0.5
    sink = sinks.astype(jnp.float32).reshape(N_KV_HEADS, Q_PER_KV)
    q = q.reshape(bsz, L, N_KV_HEADS, Q_PER_KV, HEAD_DIM)
    qm, qr = q[:, :N_META], q[:, N_META:]
    km, kr = k[:, :N_META], k[:, N_META:]
    vm, vr = v[:, :N_META], v[:, N_META:]

    s_m = jnp.einsum('bqhgd,bkhd->bhgqk', qm, km).astype(jnp.float32) * scale
    mask_m = jnp.tril(jnp.ones((N_META, N_META), dtype=bool))
    p_m = sink_softmax(s_m, mask_m, sink).astype(v.dtype)
    o_m = jnp.einsum('bhgqk,bkhd->bqhgd', p_m, vm).reshape(bsz, N_META, ATTN_WIDTH)

    def banded(t_real, t_meta):
        tb = t_real.reshape(bsz, nb, ATTN_BLOCK, N_KV_HEADS, HEAD_DIM)
        prev = jnp.concatenate([jnp.zeros_like(tb[:, :1]), tb[:, :-1]], axis=1)
        meta = jnp.broadcast_to(t_meta[:, None], (bsz, nb, N_META, N_KV_HEADS, HEAD_DIM))
        return jnp.concatenate([meta, prev, tb], axis=2)

    kc = banded(kr, km)
    vc = banded(vr, vm)
    qb = qr.reshape(bsz, nb, ATTN_BLOCK, N_KV_HEADS, Q_PER_KV, HEAD_DIM)
    qi = jnp.arange(ATTN_BLOCK)[:, None]
    kj = jnp.arange(2 * ATTN_BLOCK)[None, :] - ATTN_BLOCK
    diff = qi - kj
    band = (diff >= 0) & (diff < WINDOW)
    has_prev = (jnp.arange(nb) > 0)[:, None, None]
    band = band[None] & (has_prev | (kj >= 0)[None])
    mask = jnp.concatenate([jnp.ones((nb, ATTN_BLOCK, N_META), dtype=bool), band], axis=-1)
    s = jnp.einsum('bnqhgd,bnkhd->bnhgqk', qb, kc).astype(jnp.float32) * scale
    p = sink_softmax(s, mask[None, :, None, None], sink).astype(v.dtype)
    o_r = jnp.einsum('bnhgqk,bnkhd->bnqhgd', p, vc).reshape(bsz, S, ATTN_WIDTH)
    return jnp.concatenate([o_m, o_r], axis=1)


def s5_ssm(u, a_re, a_im, log_dt, b_re, b_im, c_re, c_im, d_skip, w_glu, b_glu):
    f32 = jnp.float32
    bsz, L = u.shape[0], u.shape[1]
    ug = u.astype(f32).reshape(bsz, L, N_SSM_GROUPS, SSM_GROUP)
    dt = jnp.exp(log_dt.astype(f32))[:, None]
    lam_re = jnp.minimum(a_re.astype(f32), -1e-4)
    lam_im = a_im.astype(f32)
    z_re, z_im = lam_re * dt, lam_im * dt
    mag = jnp.exp(z_re)
    abar_re, abar_im = mag * jnp.cos(z_im), mag * jnp.sin(z_im)
    den = lam_re * lam_re + lam_im * lam_im
    n_re, n_im = abar_re - 1.0, abar_im
    coef_re = (n_re * lam_re + n_im * lam_im) / den
    coef_im = (n_im * lam_re - n_re * lam_im) / den
    br, bi = b_re.astype(f32), b_im.astype(f32)
    bb_re = coef_re[..., None] * br - coef_im[..., None] * bi
    bb_im = coef_re[..., None] * bi + coef_im[..., None] * br
    x_re = jnp.einsum('blgc,gpc->lbgp', ug, bb_re)
    x_im = jnp.einsum('blgc,gpc->lbgp', ug, bb_im)
    a_re_t = jnp.broadcast_to(abar_re[None, None], (L, 1, N_SSM_GROUPS, SSM_STATE))
    a_im_t = jnp.broadcast_to(abar_im[None, None], (L, 1, N_SSM_GROUPS, SSM_STATE))

    def combine(left, right):
        ar_l, ai_l, br_l, bi_l = left
        ar_r, ai_r, br_r, bi_r = right
        return (ar_r * ar_l - ai_r * ai_l,
                ar_r * ai_l + ai_r * ar_l,
                ar_r * br_l - ai_r * bi_l + br_r,
                ar_r * bi_l + ai_r * br_l + bi_r)

    _, _, h_re, h_im = lax.associative_scan(combine, (a_re_t, a_im_t, x_re, x_im), axis=0)
    y = (jnp.einsum('gcp,lbgp->blgc', c_re.astype(f32), h_re)
         - jnp.einsum('gcp,lbgp->blgc', c_im.astype(f32), h_im)
         + d_skip.astype(f32).reshape(N_SSM_GROUPS, SSM_GROUP) * ug)
    y = jax.nn.gelu(y.reshape(bsz, L, SSM_WIDTH))
    y = y * jax.nn.sigmoid(y @ w_glu.astype(f32) + b_glu.astype(f32))
    return y.astype(u.dtype)


def moe_ffn(x, w_router, b_router, w1, b1, w2, b2):
    bsz, L, D = x.shape
    N = bsz * L
    A = N * TOP_K
    xf = x.reshape(N, D)
    logits = (xf @ w_router + b_router).astype(jnp.float32)
    top_val, top_idx = lax.top_k(logits, TOP_K)
    gates = jax.nn.softmax(top_val, axis=-1)
    e_flat = top_idx.reshape(A)
    order = jnp.argsort(e_flat)
    e_sorted = e_flat[order]
    tok_sorted = order // TOP_K
    counts = jnp.bincount(e_flat, length=N_EXPERTS)
    starts = jnp.cumsum(counts) - counts
    padded = ((counts + MOE_ROW_BLOCK - 1) // MOE_ROW_BLOCK) * MOE_ROW_BLOCK
    pad_ends = jnp.cumsum(padded)
    pad_starts = pad_ends - padded
    dest = pad_starts[e_sorted] + (jnp.arange(A) - starts[e_sorted])
    n_blocks = (A + MOE_ROW_BLOCK - 1) // MOE_ROW_BLOCK + N_EXPERTS
    n_rows = n_blocks * MOE_ROW_BLOCK
    row_tok = jnp.full((n_rows,), N, dtype=jnp.int32).at[dest].set(tok_sorted.astype(jnp.int32))
    x_pad = jnp.concatenate([xf, jnp.zeros((1, D), xf.dtype)], axis=0)
    xs = x_pad[row_tok].reshape(n_blocks, MOE_ROW_BLOCK, D)
    block_start = jnp.arange(n_blocks) * MOE_ROW_BLOCK
    block_e = jnp.minimum(jnp.searchsorted(pad_ends, block_start, side='right'), N_EXPERTS - 1)

    def expert_rows(args):
        xb, e = args
        hdn = xb @ w1[e] + b1[e]
        g = jnp.minimum(hdn[:, 0::2], SWIGLU_LIMIT)
        up = jnp.clip(hdn[:, 1::2], -SWIGLU_LIMIT, SWIGLU_LIMIT)
        act = g * jax.nn.sigmoid(SWIGLU_ALPHA * g) * (up + 1.0)
        return act @ w2[e] + b2[e]

    ys = lax.map(expert_rows, (xs, block_e)).reshape(n_rows, D)
    y_sorted = ys[dest].astype(jnp.float32)
    w_sorted = gates.reshape(A)[order]
    out = jnp.zeros((N, D), jnp.float32).at[tok_sorted].add(y_sorted * w_sorted[:, None])
    return out.astype(x.dtype).reshape(bsz, L, D)


def setup_inputs(seed: int = 0) -> dict:
    key = jax.random.key(seed)
    ks = jax.random.split(key, 28)
    f32 = jnp.float32

    def nrm(k, shape, s):
        return jax.random.normal(k, shape, f32) * s

    n_idx = jnp.arange(SSM_STATE, dtype=f32)
    return {
        "x": nrm(ks[0], (BATCH, SEQ, D_MODEL), 1.0),
        "meta_tokens": nrm(ks[1], (N_META, D_MODEL), 1.0),
        "g_mix": 1.0 + nrm(ks[2], (DEPTH, D_MODEL), 0.02),
        "w_in": nrm(ks[3], (DEPTH, D_MODEL, IN_WIDTH), D_MODEL ** -0.5),
        "b_in": nrm(ks[4], (DEPTH, IN_WIDTH), 0.01),
        "attn_sinks": nrm(ks[5], (DEPTH, N_Q_HEADS), 0.5),
        "ssm_a_re": -0.5 + nrm(ks[6], (DEPTH, N_SSM_GROUPS, SSM_STATE), 0.01),
        "ssm_a_im": math.pi * n_idx + nrm(ks[7], (DEPTH, N_SSM_GROUPS, SSM_STATE), 0.01),
        "ssm_log_dt": jax.random.uniform(ks[8], (DEPTH, N_SSM_GROUPS), f32, math.log(DT_MIN), math.log(DT_MAX)),
        "ssm_b_re": nrm(ks[9], (DEPTH, N_SSM_GROUPS, SSM_STATE, SSM_GROUP), (2 * SSM_GROUP) ** -0.5),
        "ssm_b_im": nrm(ks[10], (DEPTH, N_SSM_GROUPS, SSM_STATE, SSM_GROUP), (2 * SSM_GROUP) ** -0.5),
        "ssm_c_re": nrm(ks[11], (DEPTH, N_SSM_GROUPS, SSM_GROUP, SSM_STATE), C_INIT_SCALE),
        "ssm_c_im": nrm(ks[12], (DEPTH, N_SSM_GROUPS, SSM_GROUP, SSM_STATE), C_INIT_SCALE),
        "ssm_d": nrm(ks[13], (DEPTH, SSM_WIDTH), 1.0),
        "w_glu": nrm(ks[14], (DEPTH, SSM_WIDTH, SSM_WIDTH), SSM_WIDTH ** -0.5),
        "b_glu": nrm(ks[15], (DEPTH, SSM_WIDTH), 0.01),
        "g_attn_out": 1.0 + nrm(ks[16], (DEPTH, ATTN_WIDTH), 0.02),
        "g_ssm_out": 1.0 + nrm(ks[17], (DEPTH, SSM_WIDTH), 0.02),
        "w_out": nrm(ks[18], (DEPTH, MIX_WIDTH, D_MODEL), MIX_WIDTH ** -0.5),
        "b_out": nrm(ks[19], (DEPTH, D_MODEL), 0.01),
        "g_ffn": 1.0 + nrm(ks[20], (DEPTH, D_MODEL), 0.02),
        "w_router": nrm(ks[21], (DEPTH, D_MODEL, N_EXPERTS), D_MODEL ** -0.5),
        "b_router": nrm(ks[22], (DEPTH, N_EXPERTS), 0.01),
        "w_mlp1": nrm(ks[23], (DEPTH, N_EXPERTS, D_MODEL, 2 * D_FF), D_MODEL ** -0.5),
        "b_mlp1": nrm(ks[24], (DEPTH, N_EXPERTS, 2 * D_FF), 0.01),
        "w_mlp2": nrm(ks[25], (DEPTH, N_EXPERTS, D_FF, D_MODEL), D_FF ** -0.5),
        "b_mlp2": nrm(ks[26], (DEPTH, N_EXPERTS, D_MODEL), 0.01),
        "g_final": 1.0 + nrm(ks[27], (D_MODEL,), 0.02),
    }


def reference(x, meta_tokens, g_mix, w_in, b_in, attn_sinks, ssm_a_re, ssm_a_im, ssm_log_dt,
              ssm_b_re, ssm_b_im, ssm_c_re, ssm_c_im, ssm_d, w_glu, b_glu, g_attn_out, g_ssm_out,
              w_out, b_out, g_ffn, w_router, b_router, w_mlp1, b_mlp1, w_mlp2, b_mlp2, g_final):
    bsz = x.shape[0]
    meta = jnp.broadcast_to(meta_tokens[None].astype(x.dtype), (bsz, N_META, D_MODEL))
    h = jnp.concatenate([meta, x], axis=1)
    L = h.shape[1]
    positions = jnp.arange(L, dtype=jnp.int32)
    splits = [ATTN_WIDTH, ATTN_WIDTH + KV_WIDTH, ATTN_WIDTH + 2 * KV_WIDTH]
    for l in range(DEPTH):
        n = rms_norm(h, g_mix[l])
        z = n @ w_in[l] + b_in[l]
        q, k, v, u = jnp.split(z, splits, axis=-1)
        q = rope(q.reshape(bsz, L, N_Q_HEADS, HEAD_DIM), positions)
        k = rope(k.reshape(bsz, L, N_KV_HEADS, HEAD_DIM), positions)
        v = v.reshape(bsz, L, N_KV_HEADS, HEAD_DIM)
        y_attn = sliding_window_attention(q, k, v, attn_sinks[l])
        y_ssm = s5_ssm(u, ssm_a_re[l], ssm_a_im[l], ssm_log_dt[l], ssm_b_re[l], ssm_b_im[l],
                       ssm_c_re[l], ssm_c_im[l], ssm_d[l], w_glu[l], b_glu[l])
        mixed = jnp.concatenate([rms_norm(y_attn, g_attn_out[l]), rms_norm(y_ssm, g_ssm_out[l])], axis=-1)
        h = h + mixed @ w_out[l] + b_out[l]
        h = h + moe_ffn(rms_norm(h, g_ffn[l]), w_router[l], b_router[l],
                        w_mlp1[l], b_mlp1[l], w_mlp2[l], b_mlp2[l])
    return rms_norm(h, g_final)[:, N_META:]
```

```cpp
#include <hip/hip_runtime.h>
#include <cstdio>
#include <cstdint>

constexpr int N_PHASES = 11;

#define GAS __attribute__((address_space(1)))
#define LAS __attribute__((address_space(3)))
typedef unsigned short bf16;
typedef short bf16x8 __attribute__((ext_vector_type(8)));
typedef short s16x4 __attribute__((ext_vector_type(4)));
typedef short v4i16_t __attribute__((ext_vector_type(4)));
typedef float f32x2 __attribute__((ext_vector_type(2)));
typedef float f32x4 __attribute__((ext_vector_type(4)));
typedef float f32x16 __attribute__((ext_vector_type(16)));
typedef unsigned u32x2 __attribute__((ext_vector_type(2)));
typedef unsigned u32x4 __attribute__((ext_vector_type(4)));
typedef __bf16 bf16x2_t __attribute__((ext_vector_type(2)));

constexpr int DM = 2048, SEQ = 8192, NBATCH = 2, NTOK = NBATCH * SEQ, NMETA = 16;
constexpr int MROWS = NTOK + 256;
constexpr int INW = 2560, ZQ = 0, ZK = 1024, ZV = 1280, ZU = 1536;
constexpr int NQH = 16, NKVH = 4, HD = 64, AW = 1024, SW = 1024;
constexpr int NEXP = 32, DFF = 2048, NPAIR = NTOK * 4;
constexpr int NG = 64, GC = 16, NS = 64, CH = 64, NCH = SEQ / CH;
constexpr float NORM_EPS = 1e-5f;
constexpr int NPOS = NMETA + SEQ;

constexpr size_t MiB = 1u << 20;
constexpr size_t WS_CTL = 0, CTL_ZERO_BYTES = 1 * MiB;
constexpr size_t WS_ROPE = 1 * MiB;
constexpr size_t WS_SSMT = 4 * MiB;
constexpr size_t SSMT_A64 = 0, SSMT_ABAR = 32768, SSMT_BBAR = 65536, SSMT_SMETA = 65536 + 524288;
constexpr size_t WS_KTAB = 6 * MiB;
constexpr size_t WS_BMAT = 9 * MiB;
constexpr size_t WS_CMAT = 25 * MiB;
constexpr size_t WS_WRT = 41 * MiB;
constexpr size_t WS_WIN = 42 * MiB;
constexpr size_t WS_WGLU = 52 * MiB;
constexpr size_t WS_WOUT = 54 * MiB;
constexpr size_t WS_SPREV = 62 * MiB;
constexpr size_t WS_GATE = 70 * MiB;
constexpr size_t WS_LISTS = 71 * MiB;
constexpr size_t WS_XN = 74 * MiB;
constexpr size_t WS_Z = 140 * MiB;
constexpr size_t WS_YA = 222 * MiB;
constexpr size_t WS_YS = 254 * MiB;
constexpr size_t WS_YG = 286 * MiB;
constexpr size_t WS_MIX = 318 * MiB;
constexpr size_t WS_H1 = 382 * MiB;
constexpr size_t WS_N2 = 510 * MiB;
constexpr size_t WS_W1T = 576 * MiB;
constexpr size_t WS_W2T = 1088 * MiB;
constexpr size_t WS_ACT = 1344 * MiB;
constexpr size_t WS_Y4 = 1600 * MiB;
constexpr size_t WS_U2 = 1856 * MiB;
constexpr size_t WS_END = 1908 * MiB;
constexpr int CW_COUNTS = 16384, CNT_STRIDE = 64;
constexpr int CW_QUEUE = 1024;
constexpr int CW_BAR = 4096;
#ifndef NHELP
#define NHELP 48
#endif
#ifndef CQ_STATIC_PCT
#define CQ_STATIC_PCT 0
#endif
constexpr int N_HELPERS = NHELP;

constexpr int RING_BYTES = 131072;
constexpr int IDS_OFF = RING_BYTES, IDS_UNITS = 20, IDS_BYTES = IDS_UNITS * 512;
constexpr int BIAS_OFF = IDS_OFF + IDS_BYTES, BIAS_UNITS = 16;
constexpr int TAB_OFF = BIAS_OFF + BIAS_UNITS * 1024;
constexpr int MISC_OFF = TAB_OFF + 1280;
constexpr int LDS_BYTES = 163840;
static_assert(MISC_OFF + 256 <= LDS_BYTES, "LDS map");

#define RLX_AGENT __ATOMIC_RELAXED, __HIP_MEMORY_SCOPE_AGENT
__device__ __forceinline__ unsigned cvtpk(float lo, float hi) { f32x2 v = {lo, hi}; bf16x2_t b = __builtin_convertvector(v, bf16x2_t); return __builtin_bit_cast(unsigned, b); }
__device__ __forceinline__ unsigned cvt4_fp8(float a, float b, float c, float d) { unsigned w; asm volatile("" : "=v"(w));   w = (unsigned)__builtin_amdgcn_cvt_pk_fp8_f32(a, b, (int)w, false); w = (unsigned)__builtin_amdgcn_cvt_pk_fp8_f32(c, d, (int)w, true); return w; }
__device__ __forceinline__ float bf2f(unsigned short h) { return __builtin_bit_cast(float, (unsigned)h << 16); }
__device__ __forceinline__ float bflo(unsigned w) { return __builtin_bit_cast(float, w << 16); }
__device__ __forceinline__ float bfhi(unsigned w) { return __builtin_bit_cast(float, w & 0xffff0000u); }
__device__ __forceinline__ float wave_sum(float v) {
#pragma unroll
    for (int o = 1; o < 64; o <<= 1) v += __shfl_xor(v, o);
    return v;
}
__device__ __forceinline__ int lane_id() { int r; asm volatile("v_mbcnt_lo_u32_b32 %0, -1, 0\n\tv_mbcnt_hi_u32_b32 %0, -1, %0" : "=v"(r)); return r; }
__device__ __forceinline__ float fast_exp2(float x) { return __builtin_amdgcn_exp2f(x); }
__device__ __forceinline__ float fast_rcp(float x) { return __builtin_amdgcn_rcpf(x); }
__device__ __forceinline__ float sigmoidf_fast(float x) { return fast_rcp(1.0f + fast_exp2(-1.4426950408889634f * x)); }
__device__ __forceinline__ void sincos_d(double x, double& s, double& c) {
    const double n = __builtin_rint(x * 0.15915494309189533577);
    double r = __builtin_fma(-n, 6.283185307179586232, x);
    r = __builtin_fma(-n, 2.4492935982947064e-16, r);
    const double r2 = r * r;
    double ts = r, ss = r, tc = 1.0, sc = 1.0;
#pragma unroll
    for (int k = 1; k <= 12; ++k) {
        tc *= -r2 / (double)((2 * k - 1) * (2 * k)); sc += tc;
        ts *= -r2 / (double)((2 * k) * (2 * k + 1)); ss += ts;
    }
    s = ss; c = sc;
}
__device__ __forceinline__ void sincos_f(float x, float& s, float& c) {
    const float rev = x * 0.15915494309189535f; const float fr = rev - __builtin_rintf(rev);
    s = __builtin_amdgcn_sinf(fr); c = __builtin_amdgcn_cosf(fr);
}

#define XB_TMO      128
#define XB_XCNT(j)  (256  + 64 * (j))
#define XB_XSUB(j)  (1280 + 64 * (j))
#define XB_XGEN(j)  (2304 + 64 * (j))
#define XB_TOP      3328
#define XB_TOPGEN   3392
#define XCD_BAR_WORDS 3456
#define XB_SPIN_CAP (1u << 22)
__device__ __forceinline__ unsigned xb_ld(unsigned* p)              { return __hip_atomic_load(p, __ATOMIC_RELAXED, __HIP_MEMORY_SCOPE_AGENT); }
__device__ __forceinline__ unsigned xb_add(unsigned* p, unsigned v) { return __hip_atomic_fetch_add(p, v, __ATOMIC_RELAXED, __HIP_MEMORY_SCOPE_AGENT); }
__device__ __forceinline__ unsigned xb_xcc_id() { return (unsigned)__builtin_amdgcn_s_getreg((3 << 11) | 20) & 0xFu; }
#define XB_SPIN(cond, bar) do { unsigned _sp = 0; while (cond) { __builtin_amdgcn_s_sleep(1); \
    if ((++_sp & 255u) == 0u) { if (xb_ld(&(bar)[XB_TMO])) break; if (_sp > XB_SPIN_CAP) { atomicAdd(&(bar)[XB_TMO], 1u); break; } } } } while (0)
struct XcdBarrier { unsigned* bar; unsigned x; volatile LAS unsigned* st; unsigned G; };
__device__ __forceinline__ XcdBarrier xcd_barrier_post(unsigned* bar, volatile LAS unsigned* st, unsigned G) {
    XcdBarrier b; b.bar = bar; b.x = xb_xcc_id(); b.st = st; b.G = G;
    if (threadIdx.x == 0) (void)xb_add(&bar[XB_XCNT(b.x)], 1u);
    return b;
}
__device__ __forceinline__ void xcd_barrier_complete(unsigned* bar, unsigned x, unsigned& nloc, unsigned& nx, const unsigned G) {
    unsigned sum, cnt, mine, sp = 0u;
    for (;;) {
        sum = 0u; cnt = 0u; mine = 0u;
#pragma unroll
        for (unsigned j = 0; j < 16; ++j) { const unsigned c = xb_ld(&bar[XB_XCNT(j)]); sum += c; cnt += (c > 0u) ? 1u : 0u; mine = (j == x) ? c : mine; }
        if (sum == G) break;
        __builtin_amdgcn_s_sleep(1);
        if ((++sp & 255u) == 0u) { if (xb_ld(&bar[XB_TMO])) break; if (sp > XB_SPIN_CAP) { atomicAdd(&bar[XB_TMO], 1u); break; } }
    }
    nloc = mine > 0u ? mine : 1u; nx = cnt > 0u ? cnt : 1u;
}
__device__ __forceinline__ void xcd_barrier_impl(const XcdBarrier& b) {
    asm volatile("s_waitcnt vmcnt(0)" ::: "memory");
    __syncthreads();
    if (threadIdx.x == 0) {
        unsigned* bar = b.bar;
        __builtin_amdgcn_s_waitcnt(0);
        unsigned nloc = b.st[0], nx = b.st[1];
        if (nloc == 0u) { xcd_barrier_complete(bar, b.x, nloc, nx, b.G); b.st[0] = nloc; b.st[1] = nx; }
        const unsigned old = xb_add(&bar[XB_XSUB(b.x)], 1u);
        const unsigned gen = old / nloc;
        if (old + 1u == (gen + 1u) * nloc) {
            __builtin_amdgcn_fence(__ATOMIC_RELEASE, "agent");
            asm volatile("s_waitcnt vmcnt(0)" ::: "memory");
            const unsigned og = xb_add(&bar[XB_TOP], 1u);
            const unsigned tg = og / nx;
            if (og + 1u == (tg + 1u) * nx) xb_add(&bar[XB_TOPGEN], 1u);
            else XB_SPIN(xb_ld(&bar[XB_TOPGEN]) == tg, bar);
            __builtin_amdgcn_fence(__ATOMIC_ACQUIRE, "agent");
            xb_add(&bar[XB_XGEN(b.x)], 1u);
            asm volatile("s_waitcnt vmcnt(0)" ::: "memory");
        } else {
            XB_SPIN(xb_ld(&bar[XB_XGEN(b.x)]) == gen, bar);
            __builtin_amdgcn_fence(__ATOMIC_ACQUIRE, "agent");
            asm volatile("s_waitcnt vmcnt(0)" ::: "memory");
        }
    }
    __syncthreads();
}

__device__ __forceinline__ void grid_bar(unsigned* ctl, volatile LAS unsigned* MISC, int which, unsigned G) {
    XcdBarrier b; b.bar = ctl + CW_BAR + which * XCD_BAR_WORDS; b.x = xb_xcc_id(); b.st = MISC + 8 + 2 * which; b.G = G;
    xcd_barrier_impl(b);
}
namespace pg8 {
constexpr int BM = 256, BK = 64, HALF = 128, HTB = HALF * BK * 2, STAGE_BYTES = 8 * HTB, NXCD = 8, WGM = 8;
__host__ __device__ __forceinline__ int lds_byte(int r, int c) { const int st = (r >> 4) * 2 + (c >> 5), rr = r & 15, cc = c & 31, ob = rr * 64 + cc * 2; return st * 1024 + (ob ^ (((ob >> 9) & 1) << 5)); }
__host__ __device__ __forceinline__ void stage_rc(int b, int& R, int& C) { const int st = b / 1024, sb = b % 1024, swz = sb ^ (((sb >> 9) & 1) << 5); R = (st >> 1) * 16 + swz / 64; C = (st & 1) * 32 + (swz % 64) / 2; }
__host__ __device__ __forceinline__ int perm32(int rho) { const int n = rho >> 4, i = rho & 15; return 8 * (i >> 2) + 4 * n + (i & 3); }
typedef int i32x4 __attribute__((ext_vector_type(4)));
typedef int i32x8 __attribute__((ext_vector_type(8)));
typedef i32x8 Frag;
template <int ESZ> __device__ __forceinline__ Frag ldfrag(const LAS unsigned char* p) { const i32x4 x = *(const LAS i32x4*)p, y = *(const LAS i32x4*)(p + 1024); return __builtin_shufflevector(x, y, 0, 1, 2, 3, 4, 5, 6, 7); }
__device__ __forceinline__ bf16x8 flo(Frag f) { return __builtin_bit_cast(bf16x8, __builtin_shufflevector(f, f, 0, 1, 2, 3)); }
__device__ __forceinline__ bf16x8 fhi(Frag f) { return __builtin_bit_cast(bf16x8, __builtin_shufflevector(f, f, 4, 5, 6, 7)); }
struct Unit { int pm, pn, ord; };
struct StaticOrder {
    int nM, nN, nwg, G, c;
    __device__ void init(int nM_, int nN_, int G_, int c_) { nM = nM_; nN = nN_; nwg = nM * nN; G = G_; c = c_; }
    __device__ bool next(int i, Unit& u) const {
        const int L = i * G + c; if (L >= nwg) return false;
        int wgid = L; { const int q = nwg / NXCD, r = nwg % NXCD, xcd = wgid % NXCD, off = wgid / NXCD; wgid = (xcd < r ? xcd * (q + 1) : r * (q + 1) + (xcd - r) * q) + off; }
        const int nig = WGM * nN, gid = wgid / nig, fm = gid * WGM, gsz = (nM - fm) < WGM ? (nM - fm) : WGM;
        u.pm = fm + ((wgid % nig) % gsz); u.pn = (wgid % nig) / gsz; u.ord = i; return true;
    }
};
template <class Prob, class Epi, bool ALIGN_EPI>
__device__ __forceinline__ void gemm_phase(LAS unsigned char* lds, const Prob& P, const Epi& E, const int wid  ) {
    int lane = lane_id(); asm volatile("" : "+v"(lane));
    const int tid = wid * 64 + lane; const int wr = wid >> 2, wc = wid & 3, fr = lane & 15, fq = lane >> 4;
    constexpr int ESZ = Prob::ESZ; const int K = P.K, nt = K * ESZ / 128;
    unsigned voffB[2];
#pragma unroll
    for (int i = 0; i < 2; ++i) { int R, C; stage_rc(tid * 16 + i * 8192, R, C); int Rb;
        if constexpr (Epi::PERM == 2) Rb = (R >> 5) * 64 + ((R >> 2) & 3) * 16 + ((R >> 4) & 1) * 4 + (R & 3);
        else if constexpr (Epi::PERM == 3) Rb = (R >> 5) * 64 + ((R >> 2) & 3) * 16 + (R & 3) * 2 + ((R >> 4) & 1);
        else Rb = Epi::PERM ? ((R & ~31) + perm32(R & 31)) : R;
        voffB[i] = (unsigned)(Rb * K * ESZ + C * 2); }
    const size_t kstep = (size_t)(BK * 2);
    const size_t hstepB = (size_t)(Epi::PERM >= 2 ? 8 : HALF) * K * ESZ;
    const unsigned ldsw0 = (unsigned)wid * 1024u; const unsigned ldsw = ldsw0;
    const LAS unsigned char* apt = lds + lds_byte(wr * 64 + fr, fq * 8); const LAS unsigned char* bpt = lds + 4 * HTB + lds_byte(wc * 32 + fr, fq * 8);
    asm volatile("" : "+v"(apt), "+v"(bpt));
#define PG8_SA(b, h) (((b) * 2 + (h)) * HTB)
#define PG8_SB(b, h) ((4 + (b) * 2 + (h)) * HTB)
#define PG8_STAGE(bufoff, rs, soff, voff) do { _Pragma("unroll") for (int _i = 0; _i < 2; ++_i) \
        __builtin_amdgcn_raw_ptr_buffer_load_lds((rs), (LAS void*)(lds + (bufoff) + ldsw + _i * 8192), 16, (int)(voff)[_i], (int)(soff), 0, 0); } while (0)
#define PG8_LDA(dst, b, h) do { _Pragma("unroll") for (int m = 0; m < 4; ++m) dst[m] = ldfrag<ESZ>(apt + PG8_SA(b, h) + m * 2048); } while (0)
#define PG8_LDB(dst, b, h) do { _Pragma("unroll") for (int n = 0; n < 2; ++n) dst[n] = ldfrag<ESZ>(bpt + (PG8_SB(b, h) - 4 * HTB) + n * 2048); } while (0)
#define PG8_MMA(ai, bj, At, Bt) do { __builtin_amdgcn_s_setprio(1); _Pragma("unroll") for (int m = 0; m < 4; ++m) _Pragma("unroll") for (int n = 0; n < 2; ++n) { \
        if constexpr (ESZ == 2) { acc[ai][bj][m][n] = __builtin_amdgcn_mfma_f32_16x16x32_bf16(flo(Bt[n]), flo(At[m]), acc[ai][bj][m][n], 0, 0, 0); \
                                  acc[ai][bj][m][n] = __builtin_amdgcn_mfma_f32_16x16x32_bf16(fhi(Bt[n]), fhi(At[m]), acc[ai][bj][m][n], 0, 0, 0); } \
        else acc[ai][bj][m][n] = __builtin_amdgcn_mfma_scale_f32_16x16x128_f8f6f4(Bt[n], At[m], acc[ai][bj][m][n], 0, 0, 0, Prob::SCALE_B, 0, Prob::SCALE_A); } \
        __builtin_amdgcn_s_setprio(0); } while (0)
#define PG8_WAIT_V(n) asm volatile("s_waitcnt vmcnt(" #n ")" ::: "memory")
#define PG8_WAIT_L(n) asm volatile("s_waitcnt lgkmcnt(" #n ")" ::: "memory")
#define PG8_BAR __builtin_amdgcn_s_barrier()
#define PG8_SCHED __builtin_amdgcn_sched_barrier(0)
    Unit cur, nxt;
    if (!P.next(0, cur)) return;
    f32x4 acc[2][2][4][2];
    E.init(acc, cur, wr, wc, fr, fq);
    Frag At[4], B0[2], B1[2];
    unsigned X[2][2], c1[2];
    P.a_off(cur, wid, X); c1[0] = X[1][0]; c1[1] = X[1][1];
    const __amdgpu_buffer_rsrc_t rsA = P.a_rsrc(), rsB = P.b_rsrc();
    unsigned cB = P.b_off(cur);
    const unsigned hB = (unsigned)hstepB, ks = (unsigned)kstep;
    PG8_STAGE(PG8_SB(0, 0), rsB, cB, voffB); PG8_STAGE(PG8_SB(0, 1), rsB, cB + hB, voffB); PG8_STAGE(PG8_SA(0, 0), rsA, 0u, X[0]); PG8_STAGE(PG8_SA(0, 1), rsA, 0u, X[1]);
    if (wr == 1) PG8_BAR;
    PG8_WAIT_V(2); PG8_BAR;
    PG8_STAGE(PG8_SB(1, 0), rsB, cB + ks, voffB); PG8_STAGE(PG8_SA(1, 0), rsA, ks, X[0]); PG8_STAGE(PG8_SB(1, 1), rsB, cB + hB + ks, voffB);
    PG8_WAIT_V(6); PG8_BAR;
    for (;;) {
        bool has_next = false; unsigned nB = cB;
        for (int t = 0; t < nt; t += 2) {
            const bool last = (t == nt - 2);
            unsigned ldsw = ldsw0; asm volatile("" : "+s"(ldsw));
            if (last) { has_next = P.next(cur.ord + 1, nxt); if (has_next) { P.a_off(nxt, wid, X); nB = P.b_off(nxt); } }
            const unsigned a1 = (unsigned)(t + 1) * ks;
            const unsigned a2 = last ? 0u : (unsigned)(t + 2) * ks, b2 = last ? nB : cB + (unsigned)(t + 2) * ks;
            const unsigned a3 = a2 + ks, b3 = b2 + ks;
            PG8_LDB(B0, 0, 0); PG8_LDB(B1, 0, 1); PG8_SCHED; PG8_LDA(At, 0, 0); PG8_STAGE(PG8_SA(1, 1), rsA, a1, c1);
            PG8_WAIT_V(8); PG8_WAIT_L(0); PG8_BAR; PG8_MMA(0, 0, At, B0); PG8_MMA(0, 1, At, B1); PG8_BAR; PG8_SCHED;
            PG8_LDA(At, 0, 1); PG8_STAGE(PG8_SB(0, 0), rsB, b2, voffB); PG8_STAGE(PG8_SB(0, 1), rsB, b2 + hB, voffB); PG8_STAGE(PG8_SA(0, 0), rsA, a2, X[0]);
            PG8_WAIT_V(8); PG8_WAIT_L(0); PG8_BAR; PG8_MMA(1, 0, At, B0); PG8_MMA(1, 1, At, B1); PG8_BAR; PG8_SCHED;
            PG8_LDB(B0, 1, 0); PG8_LDB(B1, 1, 1); PG8_SCHED; PG8_LDA(At, 1, 0); PG8_STAGE(PG8_SA(0, 1), rsA, a2, X[1]);
            PG8_WAIT_V(8); PG8_WAIT_L(0); PG8_BAR; PG8_MMA(0, 0, At, B0); PG8_MMA(0, 1, At, B1); PG8_BAR; PG8_SCHED;
            PG8_LDA(At, 1, 1); PG8_STAGE(PG8_SB(1, 0), rsB, b3, voffB); PG8_STAGE(PG8_SB(1, 1), rsB, b3 + hB, voffB); PG8_STAGE(PG8_SA(1, 0), rsA, a3, X[0]);
            PG8_WAIT_V(8); PG8_WAIT_L(0); PG8_BAR; PG8_MMA(1, 0, At, B0); PG8_MMA(1, 1, At, B1); PG8_BAR; PG8_SCHED;
        }
        c1[0] = X[1][0]; c1[1] = X[1][1]; cB = nB;
        if constexpr (ALIGN_EPI) { if (wr == 0) PG8_BAR; }
        { int t_ = lane_id(); asm volatile("" : "+v"(t_));
          E(acc, cur, wr, wc, t_ & 15, (t_ >> 4) & 3); }
        if (!has_next) break;
        { int t_ = lane_id(); asm volatile("" : "+v"(t_)); E.init(acc, nxt, wr, wc, t_ & 15, (t_ >> 4) & 3); }
        cur = nxt;
        if constexpr (ALIGN_EPI) { if (wr == 1) PG8_BAR; }
    }
    PG8_WAIT_V(0);
    if constexpr (!ALIGN_EPI) { if (wr == 0) PG8_BAR; }
    PG8_BAR;
#undef PG8_SA
#undef PG8_SB
#undef PG8_STAGE
#undef PG8_LDA
#undef PG8_LDB
#undef PG8_MMA
#undef PG8_WAIT_V
#undef PG8_WAIT_L
#undef PG8_BAR
#undef PG8_SCHED
}

struct ProbDense {
    static constexpr int ESZ = 2, SCALE_A = 0x7f7f7f7f, SCALE_B = 0x7f7f7f7f;
    const char* A; const char* Bt; int K; StaticOrder S;
    __device__ __forceinline__ bool next(int i, Unit& u) const { return S.next(i, u); }
    __device__ __forceinline__ __amdgpu_buffer_rsrc_t a_rsrc() const { return __builtin_amdgcn_make_buffer_rsrc((void*)A, 0, 0x7ffffff0, 0x00020000); }
    __device__ __forceinline__ __amdgpu_buffer_rsrc_t b_rsrc() const { return __builtin_amdgcn_make_buffer_rsrc((void*)Bt, 0, 0x7ffffff0, 0x00020000); }
    __device__ __forceinline__ unsigned b_off(const Unit& u) const { return (unsigned)u.pn * (unsigned)(BM * 2) * (unsigned)K; }
    __device__ __forceinline__ void a_off(const Unit& u, int wid, unsigned (&off)[2][2]) const {
        int tid = lane_id(); asm volatile("" : "+v"(tid)); tid += wid * 64;
#pragma unroll
        for (int i = 0; i < 2; ++i) { int R, C; stage_rc(tid * 16 + i * 8192, R, C);
#pragma unroll
            for (int h = 0; h < 2; ++h) off[h][i] = (unsigned)((u.pm * BM + h * HALF + R) * K + C) * 2u; }
    }
};
struct ProbMoe {
    static constexpr int ESZ = 1, SCALE_A = 0x7c7c7c7c, SCALE_B = 0x7c7c7c7c;
    const char* A; const char* Bt; int K; int id_shift; size_t b_estride; StaticOrder S; const LAS unsigned* tab; const LAS unsigned short* ids;
    __device__ __forceinline__ bool next(int i, Unit& u) const { return S.next(i, u); }
    __device__ __forceinline__ __amdgpu_buffer_rsrc_t a_rsrc() const { return __builtin_amdgcn_make_buffer_rsrc((void*)A, 0, 0x7ffffff0, 0x00020000); }
    __device__ __forceinline__ __amdgpu_buffer_rsrc_t b_rsrc() const { return __builtin_amdgcn_make_buffer_rsrc((void*)Bt, 0, 0x7ffffff0, 0x00020000); }
    __device__ __forceinline__ unsigned b_off(const Unit& u) const { const unsigned e = (unsigned)__builtin_amdgcn_readfirstlane((int)tab[u.pm]) & 31u; return e * (unsigned)b_estride + (unsigned)u.pn * (unsigned)BM * (unsigned)K; }
    __device__ __forceinline__ void a_off(const Unit& u, int wid, unsigned (&off)[2][2]) const {
        int tid = lane_id(); asm volatile("" : "+v"(tid)); tid += wid * 64;
        const LAS unsigned short* id = ids + (u.ord % IDS_UNITS) * 256;
#pragma unroll
        for (int i = 0; i < 2; ++i) { int R, C; stage_rc(tid * 16 + i * 8192, R, C);
#pragma unroll
            for (int h = 0; h < 2; ++h) off[h][i] = ((unsigned)id[h * HALF + R] >> id_shift) * (unsigned)K + (unsigned)C * 2u; }
    }
};
}

struct Args { const float* in[28]; float* out; unsigned char* ws; int ph_lo, ph_hi, li, pad; };
struct Frame {
    LAS unsigned char* lds; volatile LAS unsigned* MISC; unsigned* ctl; unsigned char* ws;
    int tid, lane, wave, vcu, G;
};

template <bool PERMQK>
__device__ __forceinline__ void tr_item(const float* W, int K, int N, bf16* WT, int k0, int n0, LAS unsigned* scr, int lane) {
    f32x4 v[16];
    const int a = lane & 15, q = lane >> 4;
#pragma unroll
    for (int j = 0; j < 8; ++j) {
        const int k = 2 * q + 8 * j;
        v[2 * j] = *(const f32x4*)(W + (size_t)(k0 + k) * N + n0 + 4 * a);
        v[2 * j + 1] = *(const f32x4*)(W + (size_t)(k0 + k + 1) * N + n0 + 4 * a);
    }
#pragma unroll
    for (int j = 0; j < 8; ++j)
#pragma unroll
        for (int i = 0; i < 4; ++i) scr[(4 * a + i) * 33 + q + 4 * j] = cvtpk(v[2 * j][i], v[2 * j + 1][i]);
    asm volatile("s_waitcnt lgkmcnt(0)" ::: "memory");
    const int c = lane & 7;
#pragma unroll
    for (int jj = 0; jj < 8; ++jj) {
        const int nl = (lane >> 3) + 8 * jj; const LAS unsigned* s = scr + nl * 33 + 4 * c;
        u32x4 o; o.x = s[0]; o.y = s[1]; o.z = s[2]; o.w = s[3];
        int n = n0 + nl;
        int dr = n;
        if (PERMQK) { if (n < ZV) { const int hb = n & ~63, d = n & 63; const int pos = 8 * ((d & 31) >> 2) + (d & 3) + 4 * (d >> 5); dr = hb + pos; } }
        *(u32x4*)(WT + (size_t)dr * K + k0 + 8 * c) = o;
    }
    asm volatile("s_waitcnt lgkmcnt(0)" ::: "memory");
}
constexpr float Y8_SCALE = 16.0f;
constexpr float W8_SCALE = 8.0f, A8_SCALE = 8.0f;
__device__ __forceinline__ void tr8_load(const float* W, int N, int k0, int n0, int lane, f32x4 (&v)[16]) {
    const int a = lane & 15, q = lane >> 4;
    const unsigned voff = (unsigned)((4 * q * N + 4 * a) * 4);
    const char* base = (const char*)(W + (size_t)k0 * N + n0);
#pragma unroll
    for (int j = 0; j < 4; ++j)
#pragma unroll
        for (int r = 0; r < 4; ++r) v[4 * j + r] = *(const f32x4*)(base + (size_t)(16 * j + r) * N * 4 + voff);
}
__device__ __forceinline__ void tr8_store(const f32x4 (&v)[16], unsigned char* WT, int K, int k0, int n0, LAS unsigned* scr, int lane) {
    const int a = lane & 15, q = lane >> 4;
#pragma unroll
    for (int j = 0; j < 4; ++j)
#pragma unroll
        for (int i = 0; i < 4; ++i) scr[(4 * a + i) * 17 + q + 4 * j] = cvt4_fp8(v[4 * j][i] * W8_SCALE, v[4 * j + 1][i] * W8_SCALE, v[4 * j + 2][i] * W8_SCALE, v[4 * j + 3][i] * W8_SCALE);
    asm volatile("s_waitcnt lgkmcnt(0)" ::: "memory");
    const int c = lane & 3;
    const unsigned voff = (unsigned)((lane >> 2) * K + 16 * c);
    unsigned char* base = WT + (size_t)n0 * K + k0;
#pragma unroll
    for (int jj = 0; jj < 4; ++jj) {
        const int nl = (lane >> 2) + 16 * jj; const LAS unsigned* sp = scr + nl * 17 + 4 * c;
        u32x4 o; o.x = sp[0]; o.y = sp[1]; o.z = sp[2]; o.w = sp[3];
        *(u32x4*)(base + (size_t)(16 * jj) * K + voff) = o;
    }
    asm volatile("s_waitcnt lgkmcnt(0)" ::: "memory");
}
struct SsmP { float zre, zim, are, aim, cre, cim; };
__device__ __forceinline__ SsmP ssm_param(const float* a_re, const float* a_im, const float* log_dt, int g, int p) {
    SsmP r; const float dt = __expf(log_dt[g]); const float lre = fminf(a_re[g * NS + p], -1e-4f), lim = a_im[g * NS + p];
    r.zre = lre * dt; r.zim = lim * dt;
    const float mag = __expf(r.zre); float s, c; sincos_f(r.zim, s, c);
    r.are = mag * c; r.aim = mag * s;
    const float den = lre * lre + lim * lim, nre = r.are - 1.0f, nim = r.aim;
    r.cre = (nre * lre + nim * lim) / den; r.cim = (nim * lre - nre * lim) / den;
    return r;
}
__device__ __forceinline__ void ssm_pow(const SsmP& q, int d, float& pre, float& pim) {
    const float mag = __expf(q.zre * (float)d); float s, c; sincos_f(q.zim * (float)d, s, c); pre = mag * c; pim = mag * s;
}

constexpr int CQ_W1 = 32 * 32 * 64, CQ_TOTAL = CQ_W1 + 32 * 32 * 32;
struct CqItem { const float* src; unsigned char* dst; int N; };
__device__ __forceinline__ CqItem cq_decode(const float* w1, const float* w2, unsigned char* ws, int it) {
    CqItem c;
    if (it < CQ_W1) { const int e = it >> 11, kb = (it >> 6) & 31, nb = it & 63; c.N = 4096; c.src = w1 + ((size_t)e * 2048 + kb * 64) * 4096 + nb * 64; c.dst = ws + WS_W1T + ((size_t)e * 4096 + nb * 64) * 2048 + kb * 64; }
    else { const int i2 = it - CQ_W1; const int e = i2 >> 10, kb = (i2 >> 5) & 31, nb = i2 & 31; c.N = 2048; c.src = w2 + ((size_t)e * 2048 + kb * 64) * 2048 + nb * 64; c.dst = ws + WS_W2T + ((size_t)e * 2048 + nb * 64) * 2048 + kb * 64; }
    return c;
}
__device__ __forceinline__ void convert_static(Frame& F, const float* w1, const float* w2, int lo, int hi, int w, int NW) {
    LAS unsigned* scr = (LAS unsigned*)(F.lds + F.wave * 8704);
    f32x4 va[16], vb[16];
    if ((hi - lo) % (2 * NW) == 0 && hi > lo) {
        const int last = lo + w + ((hi - lo) / NW - 1) * NW;
        { const CqItem c = cq_decode(w1, w2, F.ws, lo + w); tr8_load(c.src, c.N, 0, 0, F.lane, va); }
        for (int it = lo + w; it < hi; it += 2 * NW) {
            const int it2 = it + NW; int it3 = it2 + NW; it3 = it3 < hi ? it3 : last;
            const CqItem c0 = cq_decode(w1, w2, F.ws, it), c2 = cq_decode(w1, w2, F.ws, it2), c3 = cq_decode(w1, w2, F.ws, it3);
            tr8_load(c2.src, c2.N, 0, 0, F.lane, vb); __builtin_amdgcn_sched_barrier(0);
            tr8_store(va, c0.dst, 2048, 0, 0, scr, F.lane); __builtin_amdgcn_sched_barrier(0);
            tr8_load(c3.src, c3.N, 0, 0, F.lane, va); __builtin_amdgcn_sched_barrier(0);
            tr8_store(vb, c2.dst, 2048, 0, 0, scr, F.lane); __builtin_amdgcn_sched_barrier(0);
        }
    } else {
        for (int it = lo + w; it < hi; it += NW) { const CqItem c = cq_decode(w1, w2, F.ws, it); tr8_load(c.src, c.N, 0, 0, F.lane, va); tr8_store(va, c.dst, 2048, 0, 0, scr, F.lane); }
    }
}
constexpr int CQ_SUB = 8;
__device__ __forceinline__ void convert_queue(Frame& F, const float* w1, const float* w2, int lo, int hi, unsigned* q, int first) {
    LAS unsigned* scr = (LAS unsigned*)(F.lds + F.wave * 8704);
    f32x4 va[16], vb[16];
    const unsigned nsub = (unsigned)(hi - lo) / CQ_SUB;
    unsigned live;
    { unsigned v = 0xffffffffu; if (F.lane < CQ_SUB) v = __hip_atomic_load(q + 64 * F.lane, RLX_AGENT); live = (unsigned)__builtin_amdgcn_ballot_w64(v < nsub); }
    for (int jj = 0; jj < CQ_SUB; ++jj) {
        const int j = (first + jj) & (CQ_SUB - 1);
        if (!((live >> j) & 1u)) continue;
        unsigned* qj = q + 64 * j; const int base = lo + j * (int)nsub;
        unsigned t = 0u;
        if (F.lane == 0) t = __hip_atomic_fetch_add(qj, 4u, RLX_AGENT);
        t = (unsigned)__builtin_amdgcn_readfirstlane((int)t);
        while (t < nsub) {
            const int it = base + (int)t;
            unsigned tn = 0u;
            if (F.lane == 0) tn = __hip_atomic_fetch_add(qj, 4u, RLX_AGENT);
            const CqItem c0 = cq_decode(w1, w2, F.ws, it), c1 = cq_decode(w1, w2, F.ws, it + 1), c2 = cq_decode(w1, w2, F.ws, it + 2), c3 = cq_decode(w1, w2, F.ws, it + 3);
            tr8_load(c0.src, c0.N, 0, 0, F.lane, va); tr8_load(c1.src, c1.N, 0, 0, F.lane, vb); __builtin_amdgcn_sched_barrier(0);
            tr8_store(va, c0.dst, 2048, 0, 0, scr, F.lane); __builtin_amdgcn_sched_barrier(0);
            tr8_load(c2.src, c2.N, 0, 0, F.lane, va); __builtin_amdgcn_sched_barrier(0);
            tr8_store(vb, c1.dst, 2048, 0, 0, scr, F.lane); __builtin_amdgcn_sched_barrier(0);
            tr8_load(c3.src, c3.N, 0, 0, F.lane, vb); __builtin_amdgcn_sched_barrier(0);
            tr8_store(va, c2.dst, 2048, 0, 0, scr, F.lane); __builtin_amdgcn_sched_barrier(0);
            tr8_store(vb, c3.dst, 2048, 0, 0, scr, F.lane); __builtin_amdgcn_sched_barrier(0);
            t = (unsigned)__builtin_amdgcn_readfirstlane((int)tn);
        }
    }
}

__device__ __forceinline__ void p0_prologue(Frame& F, const Args& A) {
    const int gw = F.vcu * 8 + F.wave, NGW = F.G * 8;
    const int lane = F.lane;
    unsigned char* ws = F.ws;
    LAS unsigned* scr = (LAS unsigned*)(F.lds + F.wave * 8704);
    {
        for (int it = gw; it < 32 * 40; it += NGW) { const int kb = it / 40, nb = it % 40; tr_item<true>(A.in[3], 2048, INW, (bf16*)(ws + WS_WIN), kb * 64, nb * 64, scr, lane); }
    }
    {
        const float* x = A.in[0]; const float* meta = A.in[1]; const float* gm = A.in[2]; bf16* XN = (bf16*)(ws + WS_XN);
        for (int m = gw; m < MROWS; m += NGW) {
            u32x2* o8 = (u32x2*)(XN + (size_t)m * DM) + lane;
            if (m >= NTOK + NMETA) {
#pragma unroll
                for (int j = 0; j < 8; ++j) o8[64 * j] = (u32x2){0u, 0u};
                continue; }
            const f32x4* xr = (const f32x4*)(m < NTOK ? x + (size_t)m * DM : meta + (size_t)(m - NTOK) * DM) + lane;
            f32x4 v[8]; float s = 0.f;
#pragma unroll
            for (int j = 0; j < 8; ++j) { v[j] = xr[64 * j]; s += (v[j].x * v[j].x + v[j].y * v[j].y) + (v[j].z * v[j].z + v[j].w * v[j].w); }
            const float rstd = 1.0f / sqrtf(wave_sum(s) * (1.0f / DM) + NORM_EPS);
#pragma unroll
            for (int j = 0; j < 8; ++j) { const f32x4 g = ((const f32x4*)gm)[lane + 64 * j]; o8[64 * j] = (u32x2){cvtpk(v[j].x * rstd * g.x, v[j].y * rstd * g.y), cvtpk(v[j].z * rstd * g.z, v[j].w * rstd * g.w)}; }
        }
    }
    const int gt = gw * 64 + lane, NGT = NGW * 64;
    {
        f32x2* T = (f32x2*)(ws + WS_ROPE);
        for (int i = gt; i < NPOS * 32; i += NGT) { const int pos = i >> 5, d = i & 31;
            const float invf = exp2f(-(float)d * (13.287712379549449f / 32.0f)); const float ang = (float)pos * invf;
            double s, c; sincos_d((double)ang, s, c); T[i] = (f32x2){(float)c, (float)s}; }
    }
    {
        const float* wr = A.in[21]; bf16* WT = (bf16*)(ws + WS_WRT);
        for (int i = gt; i < 32 * 2048; i += NGT) { const int e = i >> 11, k = i & 2047; WT[i] = (bf16)(cvtpk(wr[k * 32 + e], 0.f) & 0xffffu); }
    }
    const float* a_re = A.in[6]; const float* a_im = A.in[7]; const float* log_dt = A.in[8];
    const float* b_re = A.in[9]; const float* b_im = A.in[10]; const float* c_re = A.in[11]; const float* c_im = A.in[12];
    {
        f32x2* A64 = (f32x2*)(ws + WS_SSMT + SSMT_A64); f32x2* AB = (f32x2*)(ws + WS_SSMT + SSMT_ABAR); f32x2* BB = (f32x2*)(ws + WS_SSMT + SSMT_BBAR);
        for (int i = gt; i < NG * NS; i += NGT) { const int g = i >> 6, p = i & 63;
            const double dt = exp((double)log_dt[g]); const double lre = fmin((double)a_re[i], -1e-4), lim = (double)a_im[i];
            const double zre = lre * dt, zim = lim * dt; double s, c; sincos_d(zim, s, c); const double mag = exp(zre);
            const double are = mag * c, aim = mag * s; const double den = lre * lre + lim * lim, nre = are - 1.0, nim = aim;
            const double cre = (nre * lre + nim * lim) / den, cim = (nim * lre - nre * lim) / den;
            double s64, c64; sincos_d(zim * 64.0, s64, c64); const double m64 = exp(zre * 64.0);
            A64[i] = (f32x2){(float)(m64 * c64), (float)(m64 * s64)}; AB[i] = (f32x2){(float)are, (float)aim};
#pragma unroll
            for (int cc = 0; cc < GC; ++cc) { const double br = (double)b_re[(size_t)i * GC + cc], bi = (double)b_im[(size_t)i * GC + cc];
                BB[(size_t)i * GC + cc] = (f32x2){(float)(cre * br - cim * bi), (float)(cre * bi + cim * br)}; }
        }
    }
}

__device__ __forceinline__ void late_tables(Frame& F, const Args& A, int idx, int cnt) {
    unsigned char* ws = F.ws; const int lane = F.lane;
    LAS unsigned* scr = (LAS unsigned*)(F.lds + F.wave * 8704);
    const int gw = idx * 8 + F.wave, NGW = cnt * 8;
    __syncthreads();
    for (int it = gw; it < 32 * 32; it += NGW) { const int kb = it >> 5, nb = it & 31; tr_item<false>(A.in[18], 2048, 2048, (bf16*)(ws + WS_WOUT), kb * 64, nb * 64, scr, lane); }
    for (int it = gw; it < 16 * 16; it += NGW) { const int kb = it >> 4, nb = it & 15; tr_item<false>(A.in[14], 1024, 1024, (bf16*)(ws + WS_WGLU), kb * 64, nb * 64, scr, lane); }
    const float* a_re = A.in[6]; const float* a_im = A.in[7]; const float* log_dt = A.in[8];
    const float* b_re = A.in[9]; const float* b_im = A.in[10]; const float* c_re = A.in[11]; const float* c_im = A.in[12];
    {
        bf16* KT = (bf16*)(ws + WS_KTAB); bf16* BM_ = (bf16*)(ws + WS_BMAT); bf16* CM = (bf16*)(ws + WS_CMAT);
        LAS f32x2* Wl = (LAS f32x2*)(F.lds + 73728);
        LAS f32x2* El = Wl + 512;
        LAS f32x2* Cl = El + 512;
        LAS f32x2* Bl = Cl + 1024;
        for (int item = idx; item < NG * 8; item += cnt) {
            const int g = item >> 3, blk = item & 7;
            __syncthreads();
            { const int dl = F.tid >> 6, pp = F.tid & 63; const SsmP q = ssm_param(a_re, a_im, log_dt, g, pp); float pre, pim; ssm_pow(q, 8 * blk + dl, pre, pim);
              Wl[F.tid] = (f32x2){pre * q.cre - pim * q.cim, pre * q.cim + pim * q.cre};
              El[F.tid] = (f32x2){pre * q.are - pim * q.aim, pre * q.aim + pim * q.are};
#pragma unroll
              for (int k = 0; k < 2; ++k) { const int i = F.tid + 512 * k; Cl[i] = (f32x2){c_re[(size_t)g * 1024 + i], c_im[(size_t)g * 1024 + i]}; Bl[i] = (f32x2){b_re[(size_t)g * 1024 + i], b_im[(size_t)g * 1024 + i]}; } }
            __syncthreads();
            {
                const int dl = F.tid >> 6, c = (F.tid >> 2) & 15, cq = F.tid & 3;
                float acc[4] = {0.f, 0.f, 0.f, 0.f};
#pragma unroll 8
                for (int pp = 0; pp < NS; ++pp) { const f32x2 w = Wl[dl * 64 + pp], cc = Cl[c * 64 + pp];
                    const float xr = cc.x * w.x - cc.y * w.y, xi = cc.x * w.y + cc.y * w.x;
#pragma unroll
                    for (int j = 0; j < 4; ++j) { const f32x2 b = Bl[pp * 16 + 4 * cq + j]; acc[j] += xr * b.x - xi * b.y; } }
                const int dd = 8 * blk + dl + 1;
                *(u32x2*)(KT + (((size_t)g * 65 + dd) * GC + c) * GC + 4 * cq) = (u32x2){cvtpk(acc[0], acc[1]), cvtpk(acc[2], acc[3])};
                if (blk == 0 && F.tid < 64) *(u32x2*)(KT + ((size_t)g * 65) * GC * GC + 4 * F.tid) = (u32x2){0u, 0u};
            }
            {
                const int dl = F.tid >> 6, pp = F.tid & 63, s2 = 63 - (8 * blk + dl); const f32x2 w = Wl[F.tid];
                float vr[GC], vi[GC];
#pragma unroll
                for (int cc = 0; cc < GC; ++cc) { const f32x2 b = Bl[pp * 16 + cc]; vr[cc] = w.x * b.x - w.y * b.y; vi[cc] = w.x * b.y + w.y * b.x; }
                u32x4* d0 = (u32x4*)(BM_ + ((size_t)g * 128 + pp) * 1024 + s2 * 16); u32x4* d1 = (u32x4*)(BM_ + ((size_t)g * 128 + 64 + pp) * 1024 + s2 * 16);
                d0[0] = (u32x4){cvtpk(vr[0], vr[1]), cvtpk(vr[2], vr[3]), cvtpk(vr[4], vr[5]), cvtpk(vr[6], vr[7])};
                d0[1] = (u32x4){cvtpk(vr[8], vr[9]), cvtpk(vr[10], vr[11]), cvtpk(vr[12], vr[13]), cvtpk(vr[14], vr[15])};
                d1[0] = (u32x4){cvtpk(vi[0], vi[1]), cvtpk(vi[2], vi[3]), cvtpk(vi[4], vi[5]), cvtpk(vi[6], vi[7])};
                d1[1] = (u32x4){cvtpk(vi[8], vi[9]), cvtpk(vi[10], vi[11]), cvtpk(vi[12], vi[13]), cvtpk(vi[14], vi[15])};
            }
#pragma unroll
            for (int k = 0; k < 2; ++k) {
                const int i = F.tid + 512 * k; const int pb = i & 7, c = (i >> 3) & 15, dl = i >> 7, tt = 8 * blk + dl;
                float vr[8], vi[8];
#pragma unroll
                for (int j = 0; j < 8; ++j) { const int pp = pb * 8 + j; const f32x2 e = El[dl * 64 + pp], cc = Cl[c * 64 + pp];
                    vr[j] = cc.x * e.x - cc.y * e.y; vi[j] = -(cc.x * e.y + cc.y * e.x); }
                bf16* row = CM + ((size_t)g * 1024 + tt * 16 + c) * 128;
                *(u32x4*)(row + pb * 8) = (u32x4){cvtpk(vr[0], vr[1]), cvtpk(vr[2], vr[3]), cvtpk(vr[4], vr[5]), cvtpk(vr[6], vr[7])};
                *(u32x4*)(row + 64 + pb * 8) = (u32x4){cvtpk(vi[0], vi[1]), cvtpk(vi[2], vi[3]), cvtpk(vi[4], vi[5]), cvtpk(vi[6], vi[7])};
            }
        }
        __syncthreads();
    }
}

typedef const f32x4 (&AccRef)[2][2][4][2];
typedef f32x4 (&AccMut)[2][2][4][2];
__device__ __forceinline__ void acc_zero(AccMut acc) {
#pragma unroll
    for (int a = 0; a < 2; ++a)
#pragma unroll
        for (int b = 0; b < 2; ++b)
#pragma unroll
            for (int m = 0; m < 4; ++m)
#pragma unroll
                for (int n = 0; n < 2; ++n) acc[a][b][m][n] = (f32x4){0.f, 0.f, 0.f, 0.f};
}
struct EpiInProj {
    static constexpr int PERM = 1;
    __device__ __forceinline__ void init(AccMut acc, const pg8::Unit&, int, int, int, int) const { acc_zero(acc); }
    bf16* Z; const float* bias; const f32x2* rope; bf16* U2;
    __device__ __forceinline__ void operator()(AccRef acc, const pg8::Unit& u, int wr, int wc, int fr, int fq) const {
        const int colt = u.pn * 256;
        if (colt < ZV) {
            const float sc = (colt < ZK) ? 0.125f * 1.4426950408889634f : 1.0f;
            const int a = 4 * (wc & 1) + fq, d0 = 4 * a;
#pragma unroll
            for (int ai = 0; ai < 2; ++ai)
#pragma unroll
                for (int m = 0; m < 4; ++m) {
                    const int row = u.pm * 256 + ai * 128 + wr * 64 + m * 16 + fr;
                    int pos = row < NTOK ? NMETA + (row & (SEQ - 1)) : row - NTOK; pos = pos < NPOS ? pos : NPOS - 1;
                    const f32x4* rp = (const f32x4*)(rope + (size_t)pos * 32 + d0); const f32x4 r0 = rp[0], r1 = rp[1];
                    const float cs[4] = {r0.x, r0.z, r1.x, r1.z}, sn[4] = {r0.y, r0.w, r1.y, r1.w};
#pragma unroll
                    for (int bj = 0; bj < 2; ++bj) {
                        const int hcol = colt + bj * 128 + (wc >> 1) * 64;
                        const f32x4 b1 = *(const f32x4*)(bias + hcol + d0), b2 = *(const f32x4*)(bias + hcol + 32 + d0);
                        const f32x4 t1 = acc[ai][bj][m][0] + b1, t2 = acc[ai][bj][m][1] + b2;
                        float o1[4], o2[4];
#pragma unroll
                        for (int j = 0; j < 4; ++j) { o1[j] = (t1[j] * cs[j] - t2[j] * sn[j]) * sc; o2[j] = (t2[j] * cs[j] + t1[j] * sn[j]) * sc; }
                        bf16* zp = Z + (size_t)row * INW + hcol + d0;
                        *(u32x2*)zp = (u32x2){cvtpk(o1[0], o1[1]), cvtpk(o1[2], o1[3])};
                        *(u32x2*)(zp + 32) = (u32x2){cvtpk(o2[0], o2[1]), cvtpk(o2[2], o2[3])};
                    }
                }
        } else {
            const int col0 = colt + wc * 32 + 8 * fq;
#pragma unroll
            for (int bj = 0; bj < 2; ++bj) {
                const f32x4 b0 = *(const f32x4*)(bias + col0 + bj * 128), b1 = *(const f32x4*)(bias + col0 + bj * 128 + 4);
#pragma unroll
                for (int ai = 0; ai < 2; ++ai)
#pragma unroll
                    for (int m = 0; m < 4; ++m) {
                        const int row = u.pm * 256 + ai * 128 + wr * 64 + m * 16 + fr;
                        const f32x4 v0 = acc[ai][bj][m][0] + b0, v1 = acc[ai][bj][m][1] + b1;
                        const u32x4 o = (u32x4){cvtpk(v0[0], v0[1]), cvtpk(v0[2], v0[3]), cvtpk(v1[0], v1[1]), cvtpk(v1[2], v1[3])};
                        const int cc = col0 + bj * 128;
                        if (cc < ZU) *(u32x4*)(Z + (size_t)row * INW + cc) = o;
                        else { const int cu = cc - ZU, gg = cu >> 4;
                            const int bb = row < NTOK ? (row >> 13) : 2, tt = row < NTOK ? (row & (SEQ - 1)) : (row - NTOK);
                            if (row < NTOK + 256) *(u32x4*)(U2 + (((size_t)bb * NG + gg) * SEQ + tt) * GC + (cu & 8)) = o; }
                    }
            }
        }
    }
};
struct EpiGlu {
    static constexpr int PERM = 1;
    const bf16* YS; bf16* YG; const float* bias;
    __device__ __forceinline__ void init(AccMut acc, const pg8::Unit& u, int, int wc, int, int fq) const {
        const int col0 = u.pn * 256 + wc * 32 + 8 * fq;
#pragma unroll
        for (int bj = 0; bj < 2; ++bj) {
            const f32x4 b0 = *(const f32x4*)(bias + col0 + bj * 128), b1 = *(const f32x4*)(bias + col0 + bj * 128 + 4);
#pragma unroll
            for (int ai = 0; ai < 2; ++ai)
#pragma unroll
                for (int m = 0; m < 4; ++m) { acc[ai][bj][m][0] = b0; acc[ai][bj][m][1] = b1; }
        }
    }
    __device__ __forceinline__ void operator()(AccRef acc, const pg8::Unit& u, int wr, int wc, int fr, int fq) const {
        const int col0 = u.pn * 256 + wc * 32 + 8 * fq;
#pragma unroll
        for (int bj = 0; bj < 2; ++bj)
#pragma unroll
            for (int ai = 0; ai < 2; ++ai)
#pragma unroll
                for (int m = 0; m < 4; ++m) {
                    const unsigned off = (unsigned)((u.pm * 256 + ai * 128 + wr * 64 + m * 16 + fr) * SW + col0 + bj * 128) * 2u;
                    const u32x4 y = *(const u32x4*)((const char*)YS + off);
                    const f32x4 t0 = acc[ai][bj][m][0] * -1.4426950408889634f, t1 = acc[ai][bj][m][1] * -1.4426950408889634f;
                    const f32x4 d0 = (f32x4){fast_exp2(t0[0]), fast_exp2(t0[1]), fast_exp2(t0[2]), fast_exp2(t0[3])} + 1.0f, d1 = (f32x4){fast_exp2(t1[0]), fast_exp2(t1[1]), fast_exp2(t1[2]), fast_exp2(t1[3])} + 1.0f;
                    const f32x4 o0 = (f32x4){bflo(y.x), bfhi(y.x), bflo(y.y), bfhi(y.y)} * (f32x4){fast_rcp(d0[0]), fast_rcp(d0[1]), fast_rcp(d0[2]), fast_rcp(d0[3])};
                    const f32x4 o1 = (f32x4){bflo(y.z), bfhi(y.z), bflo(y.w), bfhi(y.w)} * (f32x4){fast_rcp(d1[0]), fast_rcp(d1[1]), fast_rcp(d1[2]), fast_rcp(d1[3])};
                    *(u32x4*)((char*)YG + off) = (u32x4){cvtpk(o0[0], o0[1]), cvtpk(o0[2], o0[3]), cvtpk(o1[0], o1[1]), cvtpk(o1[2], o1[3])};
                }
    }
};
struct EpiOutProj {
    static constexpr int PERM = 1;
    const float* x; bf16* H1; const float* bias;
    __device__ __forceinline__ void init(AccMut acc, const pg8::Unit& u, int wr, int wc, int fr, int fq) const {
        const int col0 = u.pn * 256 + wc * 32 + 8 * fq;
#pragma unroll
        for (int bj = 0; bj < 2; ++bj) {
            const f32x4 b0 = *(const f32x4*)(bias + col0 + bj * 128), b1 = *(const f32x4*)(bias + col0 + bj * 128 + 4);
#pragma unroll
            for (int ai = 0; ai < 2; ++ai)
#pragma unroll
                for (int m = 0; m < 4; ++m) {
                    const unsigned off = (unsigned)((u.pm * 256 + ai * 128 + wr * 64 + m * 16 + fr) * DM + col0 + bj * 128) * 4u;
                    acc[ai][bj][m][0] = *(const f32x4*)((const char*)x + off) + b0; acc[ai][bj][m][1] = *(const f32x4*)((const char*)x + off + 16) + b1;
                }
        }
    }
    __device__ __forceinline__ void operator()(AccRef acc, const pg8::Unit& u, int wr, int wc, int fr, int fq) const {
        const int col0 = u.pn * 256 + wc * 32 + 8 * fq;
#pragma unroll
        for (int bj = 0; bj < 2; ++bj)
#pragma unroll
            for (int ai = 0; ai < 2; ++ai)
#pragma unroll
                for (int m = 0; m < 4; ++m) {
                    const unsigned off = (unsigned)((u.pm * 256 + ai * 128 + wr * 64 + m * 16 + fr) * DM + col0 + bj * 128) * 2u;
                    const f32x4 v0 = acc[ai][bj][m][0], v1 = acc[ai][bj][m][1];
                    *(u32x4*)((char*)H1 + off) = (u32x4){cvtpk(v0[0], v0[1]), cvtpk(v0[2], v0[3]), cvtpk(v1[0], v1[1]), cvtpk(v1[2], v1[3])};
                }
    }
};
struct EpiMoe1 {
    static constexpr int PERM = 3;
    unsigned char* ACT; const float* b1; const LAS unsigned* tab; const LAS unsigned short* ids; const LAS unsigned char* lds_bias;
    __device__ __forceinline__ void init(AccMut acc, const pg8::Unit& u, int  , int wc, int  , int fq) const {
        const int e = __builtin_amdgcn_readfirstlane((int)tab[u.pm]) & 31;
        const __amdgpu_buffer_rsrc_t brs = __builtin_amdgcn_make_buffer_rsrc((void*)b1, 0, 0x7ffffff0, 0x00020000); const int bso = (e * 4096 + u.pn * 256 + wc * 64) * 4, bvo = 64 * fq;
        const LAS float* bl = (const LAS float*)(lds_bias) + (u.ord < BIAS_UNITS ? u.ord : 0) * 256 + wc * 64 + 16 * fq;
        const bool bl_ok = u.ord < BIAS_UNITS;
        f32x4 bv[4];
#pragma unroll
        for (int q = 0; q < 4; ++q) bv[q] = bl_ok ? *(const LAS f32x4*)(bl + 4 * q) : __builtin_bit_cast(f32x4, __builtin_amdgcn_raw_buffer_load_b128(brs, bvo + 16 * q, bso, 0));
#pragma unroll
        for (int bj = 0; bj < 2; ++bj) { const f32x4 bg = {bv[2 * bj][0], bv[2 * bj][2], bv[2 * bj + 1][0], bv[2 * bj + 1][2]}, bu = {bv[2 * bj][1], bv[2 * bj][3], bv[2 * bj + 1][1], bv[2 * bj + 1][3]};
#pragma unroll
            for (int ai = 0; ai < 2; ++ai)
#pragma unroll
                for (int m = 0; m < 4; ++m) { acc[ai][bj][m][0] = bg; acc[ai][bj][m][1] = bu; } }
    }
    __device__ __forceinline__ void operator()(AccRef acc, const pg8::Unit& u, int wr, int wc, int fr, int fq) const {
        const unsigned te = tab[u.pm]; const int e = te & 31u, nrows = (te >> 5) & 511u;
        const LAS unsigned short* id = ids + (u.ord % IDS_UNITS) * 256;
        const int col0 = u.pn * 256 + wc * 64 + 16 * fq;
        const f32x4 c7 = {7.0f, 7.0f, 7.0f, 7.0f}, cm7 = {-7.0f, -7.0f, -7.0f, -7.0f}, c1 = {1.0f, 1.0f, 1.0f, 1.0f}, c8 = {A8_SCALE, A8_SCALE, A8_SCALE, A8_SCALE};
#pragma unroll
        for (int ai = 0; ai < 2; ++ai)
#pragma unroll
            for (int m = 0; m < 4; ++m) {
                const int r = ai * 128 + wr * 64 + m * 16 + fr;
                if (r < nrows) {
                    unsigned w[2];
#pragma unroll
                    for (int bj = 0; bj < 2; ++bj) {
                        const f32x4 g = __builtin_elementwise_min(acc[ai][bj][m][0], c7), up = __builtin_elementwise_min(__builtin_elementwise_max(acc[ai][bj][m][1], cm7), c7);
                        const f32x4 t = g * (-1.702f * 1.4426950408889634f);
                        const f32x4 d = c1 + (f32x4){fast_exp2(t[0]), fast_exp2(t[1]), fast_exp2(t[2]), fast_exp2(t[3])};
                        const f32x4 o = (g * (f32x4){fast_rcp(d[0]), fast_rcp(d[1]), fast_rcp(d[2]), fast_rcp(d[3])}) * (up * c8 + c8);
                        w[bj] = cvt4_fp8(o[0], o[1], o[2], o[3]);
                    }
                    *(u32x2*)(ACT + (unsigned)((unsigned)id[r] * (unsigned)DFF + (unsigned)(col0 >> 1))) = (u32x2){w[0], w[1]};
                }
            }
    }
};
struct EpiMoe2 {
    static constexpr int PERM = 2;
    unsigned char* Y4; const float* b2; const float* gate; const LAS unsigned* tab; const LAS unsigned short* ids; const LAS unsigned char* lds_bias;
    __device__ __forceinline__ void init(AccMut acc, const pg8::Unit& u, int  , int wc, int  , int fq) const {
        const int e = __builtin_amdgcn_readfirstlane((int)tab[u.pm]) & 31;
        const __amdgpu_buffer_rsrc_t brs = __builtin_amdgcn_make_buffer_rsrc((void*)b2, 0, 0x7ffffff0, 0x00020000); const int bso = (e * DM + u.pn * 256 + wc * 64) * 4, bvo = 64 * fq;
        const LAS float* bl = (const LAS float*)(lds_bias) + (u.ord < BIAS_UNITS ? u.ord : 0) * 256 + wc * 64 + 16 * fq;
        const bool bl_ok = u.ord < BIAS_UNITS;
#pragma unroll
        for (int bj = 0; bj < 2; ++bj)
#pragma unroll
            for (int n = 0; n < 2; ++n) { const f32x4 bb = bl_ok ? *(const LAS f32x4*)(bl + bj * 8 + n * 4) : __builtin_bit_cast(f32x4, __builtin_amdgcn_raw_buffer_load_b128(brs, bvo + 32 * bj + 16 * n, bso, 0));
#pragma unroll
                for (int ai = 0; ai < 2; ++ai)
#pragma unroll
                    for (int m = 0; m < 4; ++m) acc[ai][bj][m][n] = bb; }
    }
    __device__ __forceinline__ void operator()(AccRef acc, const pg8::Unit& u, int wr, int wc, int fr, int fq) const {
        const unsigned te = tab[u.pm]; const int e = te & 31u, nrows = (te >> 5) & 511u;
        const LAS unsigned short* id = ids + (u.ord % IDS_UNITS) * 256;
        const int col0 = u.pn * 256 + wc * 64 + 16 * fq;
#pragma unroll
        for (int ai = 0; ai < 2; ++ai)
#pragma unroll
            for (int m = 0; m < 4; ++m) {
                const int r = ai * 128 + wr * 64 + m * 16 + fr;
                if (r < nrows) {
                    const unsigned pid = id[r]; const float gt = gate[pid] * Y8_SCALE;
                    unsigned w[4];
#pragma unroll
                    for (int bj = 0; bj < 2; ++bj)
#pragma unroll
                        for (int n = 0; n < 2; ++n) { const f32x4 v = acc[ai][bj][m][n] * gt; w[bj * 2 + n] = cvt4_fp8(v[0], v[1], v[2], v[3]); }
                    *(u32x4*)(Y4 + (unsigned)(pid * (unsigned)DM + (unsigned)col0)) = (u32x4){w[0], w[1], w[2], w[3]};
                }
            }
    }
};

constexpr int AT_KSTR = 72;
constexpr int AT_VSTR = 72;
constexpr int AT_NKEY = 224;
constexpr int AT_K_OFF = 0, AT_V_OFF = AT_NKEY * AT_KSTR * 2;
static_assert(AT_V_OFF + AT_NKEY * AT_VSTR * 2 <= RING_BYTES, "attention LDS");
struct AttnPre { u32x4 k[4], v[4]; };
__device__ __forceinline__ void attn_load(int tid, int unit, const bf16* Z, AttnPre& R) {
    const int b = unit >> 9, kvh = (unit >> 7) & 3, qb = unit & 127, t0 = qb * 64;
#pragma unroll
    for (int it = 0; it < 4; ++it) {
        const int ci = tid + 512 * it; const int j = ci >> 3, c = ci & 7;
        int row = -1;
        if (j < 32) { if (j < NMETA) row = NTOK + j; }
        else if (j < AT_NKEY) { const int tk = t0 - 128 + (j - 32); if (tk >= 0) row = b * SEQ + tk; }
        R.k[it] = (u32x4){0u, 0u, 0u, 0u}; R.v[it] = (u32x4){0u, 0u, 0u, 0u};
        if (row >= 0) { const bf16* zr = Z + (size_t)row * INW + kvh * 64 + 8 * c; R.k[it] = *(const u32x4*)(zr + ZK); R.v[it] = *(const u32x4*)(zr + ZV); }
    }
}
__device__ __forceinline__ void attn_unit(Frame& F, int unit, int next_unit, AttnPre& R, const bf16* Z, const float* sinks, bf16* YA) {
    const int tid = F.tid, lane = F.lane, w = F.wave;
    const int b = unit >> 9, kvh = (unit >> 7) & 3, qb = unit & 127, t0 = qb * 64;
    LAS bf16* Ks = (LAS bf16*)(F.lds + AT_K_OFF); LAS bf16* Vt = (LAS bf16*)(F.lds + AT_V_OFF);
    const int hq = kvh * 4 + (w >> 1), qh = w & 1, r32 = lane & 31, hi = lane >> 5;
    const int tq = t0 + 32 * qh + r32;
    bf16x8 qr[4];
    { const bf16* qp = Z + (size_t)(b * SEQ + tq) * INW + ZQ + hq * 64 + 8 * hi;
#pragma unroll
      for (int ks = 0; ks < 4; ++ks) qr[ks] = *(const bf16x8*)(qp + 16 * ks); }
#pragma unroll
    for (int it = 0; it < 4; ++it) {
        const int ci = tid + 512 * it; const int j = ci >> 3, c = ci & 7;
        if (j < AT_NKEY) {
            const u32x4 kv = R.k[it], vv = R.v[it];
            *(LAS u32x4*)(Ks + j * AT_KSTR + 8 * c) = kv;
            *(LAS u32x4*)(Vt + j * AT_VSTR + 8 * c) = vv;
        }
    }
    __syncthreads();
    if (next_unit >= 0) attn_load(tid, next_unit, Z, R);
    const float sink2 = sinks[hq] * 1.4426950408889634f;
    f32x16 S[6];
    float mx = sink2;
#pragma unroll
    for (int i = 0; i < 6; ++i) {
        const int jt = (i == 0) ? 0 : (qh + i);
        f32x16 s = {};
#pragma unroll
        for (int ks = 0; ks < 4; ++ks) {
            const bf16x8 kf = *(const LAS bf16x8*)(Ks + (32 * jt + r32) * AT_KSTR + 16 * ks + 8 * hi);
            s = __builtin_amdgcn_mfma_f32_32x32x16_bf16(kf, qr[ks], s, 0, 0, 0);
        }
#pragma unroll
        for (int r = 0; r < 16; ++r) {
            const int kr = (r & 3) + 8 * (r >> 2) + 4 * hi;
            bool ok;
            if (i == 0) ok = kr < NMETA;
            else { const int tk = t0 - 128 + 32 * (jt - 1) + kr; const int df = tq - tk; ok = (tk >= 0) && (df >= 0) && (df < 128); }
            s[r] = ok ? s[r] : -INFINITY;
            mx = fmaxf(mx, s[r]);
        }
        S[i] = s;
    }
    mx = fmaxf(mx, __shfl_xor(mx, 32));
    float sum = 0.f;
#pragma unroll
    for (int i = 0; i < 6; ++i)
#pragma unroll
        for (int r = 0; r < 16; ++r) { const float p = fast_exp2(S[i][r] - mx); S[i][r] = p; sum += p; }
    sum += __shfl_xor(sum, 32);
    const float inv = 1.0f / (sum + fast_exp2(sink2 - mx));
    f32x16 O[2] = {};
#pragma unroll
    for (int i = 0; i < 6; ++i) {
        const int jt = (i == 0) ? 0 : (qh + i);
#pragma unroll
        for (int s2 = 0; s2 < 2; ++s2) {
            bf16x8 pf;
            { const unsigned w0 = cvtpk(S[i][8 * s2 + 0] * inv, S[i][8 * s2 + 1] * inv), w1 = cvtpk(S[i][8 * s2 + 2] * inv, S[i][8 * s2 + 3] * inv),
                             w2 = cvtpk(S[i][8 * s2 + 4] * inv, S[i][8 * s2 + 5] * inv), w3 = cvtpk(S[i][8 * s2 + 6] * inv, S[i][8 * s2 + 7] * inv);
              pf = __builtin_bit_cast(bf16x8, (u32x4){w0, w1, w2, w3}); }
#pragma unroll
            for (int dh = 0; dh < 2; ++dh) {
                const LAS bf16* vp = Vt + (32 * jt + 16 * s2 + 4 * hi + ((lane & 15) >> 2)) * AT_VSTR + 32 * dh + 16 * ((lane >> 4) & 1) + 4 * (lane & 3);
                const s16x4 v0 = __builtin_bit_cast(s16x4, __builtin_amdgcn_ds_read_tr16_b64_v4i16((LAS v4i16_t*)vp)), v1 = __builtin_bit_cast(s16x4, __builtin_amdgcn_ds_read_tr16_b64_v4i16((LAS v4i16_t*)(vp + 8 * AT_VSTR)));
                const bf16x8 vf = (bf16x8){v0[0], v0[1], v0[2], v0[3], v1[0], v1[1], v1[2], v1[3]};
                O[dh] = __builtin_amdgcn_mfma_f32_32x32x16_bf16(pf, vf, O[dh], 0, 0, 0);
            }
        }
    }
    { const bool odd = (lane & 1) != 0;
#pragma unroll
      for (int dh = 0; dh < 2; ++dh)
#pragma unroll
        for (int k = 0; k < 8; ++k) {
            const float va = O[dh][2 * k], vb = O[dh][2 * k + 1];
            const float rcv = __shfl_xor(odd ? va : vb, 1);
            const int r = odd ? 2 * k + 1 : 2 * k, q = (r & 3) + 8 * (r >> 2) + 4 * hi;
            *(unsigned*)(YA + (size_t)(b * SEQ + t0 + 32 * qh + q) * AW + hq * 64 + 32 * dh + (r32 & ~1)) = odd ? cvtpk(rcv, vb) : cvtpk(va, rcv);
        } }
    __syncthreads();
}

constexpr int SL_STR = 68;
static_assert(128 * SL_STR * 4 + 1024 <= RING_BYTES, "sloc LDS");
__device__ __forceinline__ void sloc_unit(Frame& F, int unit, const bf16* U2, const bf16* BMAT, const unsigned char* ssmt, bf16* SPREV) {
    const int lane = F.lane, w = F.wave, ph = unit & 1, b = (unit >> 1) & 1, g = unit >> 2;
    const int l15 = lane & 15, kq = lane >> 4;
    LAS float* SL = (LAS float*)F.lds; LAS float* UM = SL + 128 * SL_STR;
    if (F.tid < 256) UM[F.tid] = bf2f(U2[(((size_t)2 * NG + g) * SEQ + (F.tid >> 4)) * GC + (F.tid & 15)]);
    {
        const bf16* up = U2 + (((size_t)b * NG + g) * SEQ + (w * 16 + l15) * CH + (kq >> 1)) * GC + 8 * (kq & 1);
        const bf16* bp = BMAT + ((size_t)g * 128 + 32 * ph + l15) * 1024 + 8 * kq;
        f32x4 acc[4] = {};
        bf16x8 ufA[4], bfA[4][4], ufB[4], bfB[4][4];
#define SL_LD(ufv, bfv, sp0) do { _Pragma("unroll") for (int j = 0; j < 4; ++j) { ufv[j] = *(const bf16x8*)(up + (size_t)(2 * ((sp0) + j)) * GC); \
            _Pragma("unroll") for (int ct = 0; ct < 4; ++ct) bfv[j][ct] = *(const bf16x8*)(bp + (size_t)((ct >> 1) * 64 + (ct & 1) * 16) * 1024 + ((sp0) + j) * 32); } } while (0)
#define SL_MM(ufv, bfv) do { _Pragma("unroll") for (int j = 0; j < 4; ++j) _Pragma("unroll") for (int ct = 0; ct < 4; ++ct) acc[ct] = __builtin_amdgcn_mfma_f32_16x16x32_bf16(bfv[j][ct], ufv[j], acc[ct], 0, 0, 0); } while (0)
        SL_LD(ufA, bfA, 0);
#pragma unroll
        for (int bb = 0; bb < 8; bb += 2) {
            SL_LD(ufB, bfB, 4 * (bb + 1)); __builtin_amdgcn_sched_barrier(0);
            SL_MM(ufA, bfA); __builtin_amdgcn_sched_barrier(0);
            if (bb + 2 < 8) { SL_LD(ufA, bfA, 4 * (bb + 2)); __builtin_amdgcn_sched_barrier(0); }
            SL_MM(ufB, bfB); __builtin_amdgcn_sched_barrier(0);
        }
#undef SL_LD
#undef SL_MM
#pragma unroll
        for (int ct = 0; ct < 4; ++ct) *(LAS f32x4*)(SL + (w * 16 + l15) * SL_STR + 16 * ct + 4 * kq) = acc[ct];
    }
    __syncthreads();
    if (w == 0 && lane < 32) {
        const int p = 32 * ph + lane, idx = g * NS + p;
        const f32x2 ab = ((const f32x2*)(ssmt + SSMT_ABAR))[idx]; const f32x2 a64 = ((const f32x2*)(ssmt + SSMT_A64))[idx]; const f32x2* bb = (const f32x2*)(ssmt + SSMT_BBAR) + (size_t)idx * GC;
        float sr = 0.f, si = 0.f;
        for (int s2 = 0; s2 < NMETA; ++s2) {
            float xr = 0.f, xi = 0.f;
#pragma unroll
            for (int c = 0; c < GC; ++c) { const float uv = UM[s2 * 16 + c]; xr += bb[c].x * uv; xi += bb[c].y * uv; }
            const float nr = ab.x * sr - ab.y * si + xr, ni = ab.x * si + ab.y * sr + xi; sr = nr; si = ni;
        }
        bf16* dst = SPREV + ((size_t)(b * NG + g) * NCH) * 128 + p;
#pragma unroll 8
        for (int k = 0; k < NCH; ++k) {
            dst[(size_t)k * 128] = (bf16)(cvtpk(sr, 0.f) & 0xffffu); dst[(size_t)k * 128 + 64] = (bf16)(cvtpk(si, 0.f) & 0xffffu);
            const float lr = SL[k * SL_STR + lane], li = SL[k * SL_STR + 32 + lane];
            const float nr = a64.x * sr - a64.y * si + lr, ni = a64.x * si + a64.y * sr + li; sr = nr; si = ni;
        }
    }
    __syncthreads();
}

constexpr int SO_KT_OFF = 0;
constexpr int SO_SP_OFF = 36864;
constexpr int SO_SP_STR = 136;
static_assert(SO_SP_OFF + 8 * 16 * SO_SP_STR * 2 <= RING_BYTES, "ssm-out LDS");
__device__ __forceinline__ float gelu_tanh(float x) { const float u = 0.7978845608028654f * (x + 0.044715f * x * x * x); return x * sigmoidf_fast(2.0f * u); }
__device__ __forceinline__ void ssm_out_unit(Frame& F, int unit, const bf16* U2, const bf16* KTAB, const bf16* CMAT, const bf16* SPREV, const float* dskip, bf16* YS) {
    const int tid = F.tid, lane = F.lane, w = F.wave;
    const int hh = unit & 1, b = (unit >> 1) & 1, g = unit >> 2;
    const int rt = 4 * hh + (w & 3), ts = w >> 2, l15 = lane & 15, kq = lane >> 4;
    const bf16* up = U2 + (((size_t)b * NG + g) * SEQ + (rt * 16 + l15) * CH + (kq >> 1)) * GC + 8 * (kq & 1);
    bf16x8 U[32];
#pragma unroll
    for (int sp = 0; sp < 32; ++sp) U[sp] = *(const bf16x8*)(up + (size_t)(2 * sp) * GC);
    u32x4 ktp[5];
    { const u32x4* src = (const u32x4*)(KTAB + (size_t)g * 65 * 256);
#pragma unroll
      for (int k = 0; k < 5; ++k) { const int i = tid + 512 * k; const bool ld = (i >= 7 * 32) && (i < 72 * 32); const u32x4 v = src[ld ? i - 7 * 32 : 0]; ktp[k] = ld ? v : (u32x4){0u, 0u, 0u, 0u}; } }
    bf16x8 SF[4];
#pragma unroll
    for (int i = 0; i < 4; ++i) SF[i] = *(const bf16x8*)(SPREV + ((size_t)(b * NG + g) * NCH + rt * 16 + l15) * 128 + 32 * i + 8 * kq);
    const LAS bf16* KT = (const LAS bf16*)(F.lds + SO_KT_OFF);
    const bf16* cm = CMAT + ((size_t)g * 1024 + l15) * 128 + 8 * kq;
    const f32x4 dsk = *(const f32x4*)(dskip + g * GC + 4 * kq);
#define SO_T(tt_) (ts ? 16 + (tt_) : ((tt_) < 16 ? (tt_) : 32 + (tt_)))
#define SO_LOAD(cfv, uuv, tt_) do { const int t_ = SO_T((tt_) < 32 ? (tt_) : 31); _Pragma("unroll") for (int i = 0; i < 4; ++i) cfv[i] = *(const bf16x8*)(cm + (size_t)t_ * 16 * 128 + 32 * i); \
        uuv = *(const u32x2*)(U2 + (((size_t)b * NG + g) * SEQ + (rt * 16 + l15) * CH + t_) * GC + 4 * kq); } while (0)
    bf16x8 cfa[4], cfb[4]; u32x2 uua, uub;
    SO_LOAD(cfa, uua, 0); SO_LOAD(cfb, uub, 1);
    { LAS u32x4* dst = (LAS u32x4*)(F.lds + SO_KT_OFF);
#pragma unroll
      for (int k = 0; k < 5; ++k) { const int i = tid + 512 * k; if (i < 72 * 32) dst[i] = ktp[k]; } }
    __syncthreads();
#pragma unroll 2
    for (int tt = 0; tt < 32; ++tt) {
        const int t = SO_T(tt);
        bf16x8 cf[4]; u32x2 uu;
        if (tt & 1) { _Pragma("unroll") for (int i = 0; i < 4; ++i) cf[i] = cfb[i]; uu = uub; SO_LOAD(cfb, uub, tt + 2); }
        else        { _Pragma("unroll") for (int i = 0; i < 4; ++i) cf[i] = cfa[i]; uu = uua; SO_LOAD(cfa, uua, tt + 2); }
        f32x4 acc0 = {}, acc1 = {};
        acc0 = __builtin_amdgcn_mfma_f32_16x16x32_bf16(cf[0], SF[0], acc0, 0, 0, 0); acc1 = __builtin_amdgcn_mfma_f32_16x16x32_bf16(cf[1], SF[1], acc1, 0, 0, 0);
        acc0 = __builtin_amdgcn_mfma_f32_16x16x32_bf16(cf[2], SF[2], acc0, 0, 0, 0); acc1 = __builtin_amdgcn_mfma_f32_16x16x32_bf16(cf[3], SF[3], acc1, 0, 0, 0);
        const LAS bf16* kb = KT + ((t + 8 - (kq >> 1)) * 16 + l15) * 16 + 8 * (kq & 1);
#pragma unroll
        for (int g4 = 0; g4 < 8; ++g4) {
            if (8 * g4 <= t) {
                const bf16x8 k0 = *(const LAS bf16x8*)(kb - (4 * g4 + 0) * 512), k1 = *(const LAS bf16x8*)(kb - (4 * g4 + 1) * 512);
                const bf16x8 k2 = *(const LAS bf16x8*)(kb - (4 * g4 + 2) * 512), k3 = *(const LAS bf16x8*)(kb - (4 * g4 + 3) * 512);
                acc0 = __builtin_amdgcn_mfma_f32_16x16x32_bf16(k0, U[4 * g4 + 0], acc0, 0, 0, 0); acc1 = __builtin_amdgcn_mfma_f32_16x16x32_bf16(k1, U[4 * g4 + 1], acc1, 0, 0, 0);
                acc0 = __builtin_amdgcn_mfma_f32_16x16x32_bf16(k2, U[4 * g4 + 2], acc0, 0, 0, 0); acc1 = __builtin_amdgcn_mfma_f32_16x16x32_bf16(k3, U[4 * g4 + 3], acc1, 0, 0, 0);
            }
        }
        const f32x4 acc = acc0 + acc1;
        const size_t row = (size_t)(b * SEQ + (rt * 16 + l15) * CH + t);
        const float y0 = gelu_tanh(acc[0] + dsk[0] * bflo(uu.x)), y1 = gelu_tanh(acc[1] + dsk[1] * bfhi(uu.x));
        const float y2 = gelu_tanh(acc[2] + dsk[2] * bflo(uu.y)), y3 = gelu_tanh(acc[3] + dsk[3] * bfhi(uu.y));
        *(u32x2*)(YS + row * SW + g * GC + 4 * kq) = (u32x2){cvtpk(y0, y1), cvtpk(y2, y3)};
    }
#undef SO_T
#undef SO_LOAD
    __syncthreads();
}

struct MixIn { u32x4 a0, a1, s0, s1; };
__device__ __forceinline__ MixIn mix_load(int m, int lane, const bf16* YA, const bf16* YG) {
    const u32x4* a = (const u32x4*)(YA + (size_t)m * AW) + lane; const u32x4* s = (const u32x4*)(YG + (size_t)m * SW) + lane;
    MixIn r; r.a0 = a[0]; r.a1 = a[64]; r.s0 = s[0]; r.s1 = s[64]; return r;
}
__device__ __forceinline__ void mixnorm_row(int m, int lane, const MixIn& in, const float* ga, const float* gs, bf16* MIX) {
    const u32x4 a0 = in.a0, a1 = in.a1, s0 = in.s0, s1 = in.s1;
    float va[16], vs[16];
    { const unsigned wa[8] = {a0.x, a0.y, a0.z, a0.w, a1.x, a1.y, a1.z, a1.w}, wsv[8] = {s0.x, s0.y, s0.z, s0.w, s1.x, s1.y, s1.z, s1.w};
#pragma unroll
      for (int i = 0; i < 8; ++i) { va[2 * i] = bflo(wa[i]); va[2 * i + 1] = bfhi(wa[i]); vs[2 * i] = bflo(wsv[i]); vs[2 * i + 1] = bfhi(wsv[i]); } }
    float qa = 0.f, qs = 0.f;
#pragma unroll
    for (int i = 0; i < 16; ++i) { qa += va[i] * va[i]; qs += vs[i] * vs[i]; }
    const float ra = 1.0f / sqrtf(wave_sum(qa) * (1.0f / AW) + NORM_EPS), rs = 1.0f / sqrtf(wave_sum(qs) * (1.0f / SW) + NORM_EPS);
#pragma unroll
    for (int h = 0; h < 2; ++h) {
        const int c0 = 8 * lane + 512 * h;
        const f32x4 g0 = *(const f32x4*)(ga + c0), g1 = *(const f32x4*)(ga + c0 + 4), k0 = *(const f32x4*)(gs + c0), k1 = *(const f32x4*)(gs + c0 + 4);
        const float* pa = va + 8 * h; const float* ps = vs + 8 * h;
        *(u32x4*)(MIX + (size_t)m * DM + c0) = (u32x4){cvtpk(pa[0] * ra * g0.x, pa[1] * ra * g0.y), cvtpk(pa[2] * ra * g0.z, pa[3] * ra * g0.w), cvtpk(pa[4] * ra * g1.x, pa[5] * ra * g1.y), cvtpk(pa[6] * ra * g1.z, pa[7] * ra * g1.w)};
        *(u32x4*)(MIX + (size_t)m * DM + AW + c0) = (u32x4){cvtpk(ps[0] * rs * k0.x, ps[1] * rs * k0.y), cvtpk(ps[2] * rs * k0.z, ps[3] * rs * k0.w), cvtpk(ps[4] * rs * k1.x, ps[5] * rs * k1.y), cvtpk(ps[6] * rs * k1.z, ps[7] * rs * k1.w)};
    }
}

constexpr int RT_NT_STR = 2056;
constexpr int RT_NT_OFF = 0, RT_PART_OFF = 16 * RT_NT_STR * 2  , RT_LOG_OFF = RT_PART_OFF + 16384, RT_SEL_OFF = RT_LOG_OFF + 8192, RT_HIST_OFF = RT_SEL_OFF + 1024, RT_BASE_OFF = RT_HIST_OFF + 128, RT_RANK_OFF = RT_BASE_OFF + 128;
static_assert(RT_RANK_OFF + 1024 <= RING_BYTES, "router LDS");
__device__ __forceinline__ void router_block(Frame& F, int rb, const bf16* H1, const float* gffn, const bf16* WRT, const float* brt, unsigned char* N2, float* GATE, int* LISTS, unsigned* counts) {
    const int lane = lane_id(), w = F.wave, tid = w * 64 + lane;
    LAS bf16* NT = (LAS bf16*)(F.lds + RT_NT_OFF); LAS float* PART = (LAS float*)(F.lds + RT_PART_OFF); LAS float* LOG = (LAS float*)(F.lds + RT_LOG_OFF);
    LAS int* SEL = (LAS int*)(F.lds + RT_SEL_OFF); LAS unsigned* HIST = (LAS unsigned*)(F.lds + RT_HIST_OFF); LAS unsigned* BASE = (LAS unsigned*)(F.lds + RT_BASE_OFF); LAS unsigned* RANK = (LAS unsigned*)(F.lds + RT_RANK_OFF);
    if (tid < 32) HIST[tid] = 0u;
    bf16x8 wb0[8], wb1[8];
    { const int l15 = lane & 15, kq = lane >> 4;
      const bf16* wp0 = WRT + (size_t)l15 * DM + 256 * w + 8 * kq; asm volatile("" : "+v"(wp0)); const bf16* wp1 = wp0 + (size_t)16 * DM; asm volatile("" : "+v"(wp1));
#pragma unroll
      for (int st = 0; st < 8; ++st) { wb0[st] = *(const bf16x8*)(wp0 + 32 * st); wb1[st] = *(const bf16x8*)(wp1 + 32 * st); } }
    u32x4 hn[4];
#pragma unroll
    for (int j = 0; j < 4; ++j) hn[j] = ((const u32x4*)(H1 + (size_t)(rb * 64 + 2 * w) * DM))[lane + 64 * j];
#pragma unroll 1
    for (int sb = 0; sb < 4; ++sb) {
        const int row0 = rb * 64 + sb * 16;
#pragma unroll 1
        for (int rr = 0; rr < 2; ++rr) {
            const int lr = 2 * w + rr, m = row0 + lr;
            u32x4 hc[4];
#pragma unroll
            for (int j = 0; j < 4; ++j) hc[j] = hn[j];
            { const int nidx = sb * 2 + rr + 1, nm = rb * 64 + ((nidx < 8 ? nidx : 7) >> 1) * 16 + 2 * w + ((nidx < 8 ? nidx : 7) & 1);
#pragma unroll
              for (int j = 0; j < 4; ++j) hn[j] = ((const u32x4*)(H1 + (size_t)nm * DM))[lane + 64 * j]; }
            float v[4][8]; float s = 0.f;
#pragma unroll
            for (int j = 0; j < 4; ++j) { const u32x4 h = hc[j];
                v[j][0] = bflo(h.x); v[j][1] = bfhi(h.x); v[j][2] = bflo(h.y); v[j][3] = bfhi(h.y); v[j][4] = bflo(h.z); v[j][5] = bfhi(h.z); v[j][6] = bflo(h.w); v[j][7] = bfhi(h.w);
#pragma unroll
                for (int i = 0; i < 8; ++i) s += v[j][i] * v[j][i]; }
            const float rstd = 1.0f / sqrtf(wave_sum(s) * (1.0f / DM) + NORM_EPS);
#pragma unroll
            for (int j = 0; j < 4; ++j) { const int c8 = 8 * (lane + 64 * j); const f32x4 g0 = *(const f32x4*)(gffn + c8), g1 = *(const f32x4*)(gffn + c8 + 4);
                float n[8];
                n[0] = v[j][0] * rstd * g0.x; n[1] = v[j][1] * rstd * g0.y; n[2] = v[j][2] * rstd * g0.z; n[3] = v[j][3] * rstd * g0.w;
                n[4] = v[j][4] * rstd * g1.x; n[5] = v[j][5] * rstd * g1.y; n[6] = v[j][6] * rstd * g1.z; n[7] = v[j][7] * rstd * g1.w;
                *(LAS u32x4*)(NT + lr * RT_NT_STR + c8) = (u32x4){cvtpk(n[0], n[1]), cvtpk(n[2], n[3]), cvtpk(n[4], n[5]), cvtpk(n[6], n[7])};
                *(u32x2*)(N2 + (size_t)m * DM + c8) = (u32x2){cvt4_fp8(n[0] * A8_SCALE, n[1] * A8_SCALE, n[2] * A8_SCALE, n[3] * A8_SCALE), cvt4_fp8(n[4] * A8_SCALE, n[5] * A8_SCALE, n[6] * A8_SCALE, n[7] * A8_SCALE)}; }
        }
        __syncthreads();
        {
            const int l15 = lane & 15, kq = lane >> 4; f32x4 a0 = {}, a1 = {};
#pragma unroll
            for (int st = 0; st < 8; ++st) {
                const int k = 256 * w + 32 * st + 8 * kq;
                const bf16x8 af = *(const LAS bf16x8*)(NT + l15 * RT_NT_STR + k);
                a0 = __builtin_amdgcn_mfma_f32_16x16x32_bf16(af, wb0[st], a0, 0, 0, 0); a1 = __builtin_amdgcn_mfma_f32_16x16x32_bf16(af, wb1[st], a1, 0, 0, 0);
            }
#pragma unroll
            for (int r = 0; r < 4; ++r) { PART[(w * 16 + 4 * kq + r) * 32 + l15] = a0[r]; PART[(w * 16 + 4 * kq + r) * 32 + 16 + l15] = a1[r]; }
        }
        __syncthreads();
        { const int r = tid >> 5, e = tid & 31; float s = brt[e];
#pragma unroll
          for (int ww = 0; ww < 8; ++ww) s += PART[(ww * 16 + r) * 32 + e];
          LOG[(sb * 16 + r) * 32 + e] = s; }
    }
    __syncthreads();
    if (tid < 64) {
        const int m = rb * 64 + tid; float tv[4]; int ti[4]; unsigned used = 0u;
        float lg[32];
#pragma unroll
        for (int e = 0; e < 32; ++e) lg[e] = LOG[tid * 32 + ((e + tid) & 31)];
#pragma unroll
        for (int k = 0; k < 4; ++k) { float best = -INFINITY; int bi = 0;
#pragma unroll
            for (int e = 0; e < 32; ++e) { const float v = lg[e]; const int ee = (e + tid) & 31;
                if (!((used >> ee) & 1u) && (v > best || (v == best && ee < bi))) { best = v; bi = ee; } }
            used |= 1u << bi; tv[k] = best; ti[k] = bi; }
        const float e1 = __expf(tv[1] - tv[0]), e2 = __expf(tv[2] - tv[0]), e3 = __expf(tv[3] - tv[0]); const float inv = 1.0f / (1.0f + e1 + e2 + e3);
        *(f32x4*)(GATE + (size_t)m * 4) = (f32x4){inv, e1 * inv, e2 * inv, e3 * inv};
#pragma unroll
        for (int k = 0; k < 4; ++k) SEL[tid * 4 + k] = ti[k];
    }
    __syncthreads();
    if (tid < 256) RANK[tid] = atomicAdd((unsigned*)&HIST[SEL[tid]], 1u);
    __syncthreads();
    if (tid < 32) BASE[tid] = HIST[tid] ? __hip_atomic_fetch_add(counts + CNT_STRIDE * tid, HIST[tid], RLX_AGENT) : 0u;
    __syncthreads();
    if (tid < 256) { const int e = SEL[tid]; LISTS[e * NTOK + BASE[e] + RANK[tid]] = rb * 256 + tid; }
    __syncthreads();
}

__device__ __forceinline__ int moe_setup(Frame& F, const unsigned* counts, const int* LISTS, int nN, pg8::StaticOrder& S, int e_lo, int e_hi, int G, int c, const float* bias, int bias_estride) {
    LAS unsigned* tab = (LAS unsigned*)(F.lds + TAB_OFF); LAS unsigned short* ids = (LAS unsigned short*)(F.lds + IDS_OFF);
    volatile LAS unsigned* MISC = F.MISC;
    __syncthreads();
    if (F.tid < 64) {
        const int ne = e_hi - e_lo, e = e_lo + F.tid; const int cnt = (F.tid < ne) ? (int)MISC[32 + e] : 0, nt = (cnt + 255) >> 8;
        int inc = nt;
#pragma unroll
        for (int d = 1; d < 32; d <<= 1) { const int o = __shfl_up(inc, d, 64); if (F.tid >= d) inc += o; }
        const int pre = inc - nt;
        for (int k = 0; k < nt; ++k) { const int r0 = k << 8, nr = cnt - r0 < 256 ? cnt - r0 : 256; tab[pre + k] = (unsigned)e | ((unsigned)nr << 5) | ((unsigned)r0 << 14); }
        if (F.tid == ne - 1) MISC[16] = (unsigned)inc; }
    __syncthreads();
    const int VM = __builtin_amdgcn_readfirstlane((int)MISC[16]);
    S.init(VM, nN, G, c);
    int nu = (VM * nN - c + G - 1) / G; nu = nu < 0 ? 0 : (nu > IDS_UNITS ? IDS_UNITS : nu);
    pg8::Unit u;
    int idv[IDS_UNITS]; float bsv[BIAS_UNITS];
#pragma unroll
    for (int i = 0; i < IDS_UNITS; ++i) if (i < nu) { S.next(i, u);
        const unsigned te = tab[u.pm]; const int e = te & 31u, nr = (te >> 5) & 511u, r0 = te >> 14;
        if (F.tid < 256) { const int r = F.tid < nr ? F.tid : 0; idv[i] = LISTS[e * NTOK + r0 + r]; }
        else if (i < BIAS_UNITS) bsv[i < BIAS_UNITS ? i : 0] = bias[(size_t)e * bias_estride + u.pn * 256 + (F.tid - 256)];
    }
#pragma unroll
    for (int i = 0; i < IDS_UNITS; ++i) if (i < nu) {
        if (F.tid < 256) ids[i * 256 + F.tid] = (unsigned short)idv[i];
        else if (i < BIAS_UNITS) ((LAS float*)(F.lds + BIAS_OFF))[i * 256 + (F.tid - 256)] = bsv[i < BIAS_UNITS ? i : 0];
    }
    __syncthreads();
    return VM;
}

struct FinIn { u32x4 h[4]; u32x2 y[4][4]; };
__device__ __forceinline__ void final_load(int m, int lane, const bf16* H1, const unsigned char* Y4, FinIn& r) {
#pragma unroll
    for (int j = 0; j < 4; ++j) r.h[j] = ((const u32x4*)(H1 + (size_t)m * DM))[lane + 64 * j];
#pragma unroll
    for (int k = 0; k < 4; ++k) { const u32x2* yr = (const u32x2*)(Y4 + ((size_t)m * 4 + k) * DM) + lane;
#pragma unroll
        for (int j = 0; j < 4; ++j) r.y[k][j] = yr[64 * j]; }
}
__device__ __forceinline__ void final_row(int m, int lane, const FinIn& in, const float* gfin, float* out) {
    float v[4][8];
#pragma unroll
    for (int j = 0; j < 4; ++j) { const u32x4 h = in.h[j];
        v[j][0] = bflo(h.x); v[j][1] = bfhi(h.x); v[j][2] = bflo(h.y); v[j][3] = bfhi(h.y); v[j][4] = bflo(h.z); v[j][5] = bfhi(h.z); v[j][6] = bflo(h.w); v[j][7] = bfhi(h.w); }
#pragma unroll
    for (int k = 0; k < 4; ++k) {
#pragma unroll
        for (int j = 0; j < 4; ++j) { const u32x2 y = in.y[k][j];
            const f32x2 a = __builtin_amdgcn_cvt_pk_f32_fp8((int)y.x, false), b2 = __builtin_amdgcn_cvt_pk_f32_fp8((int)y.x, true), c = __builtin_amdgcn_cvt_pk_f32_fp8((int)y.y, false), d = __builtin_amdgcn_cvt_pk_f32_fp8((int)y.y, true);
            v[j][0] += a.x * (1.0f / Y8_SCALE); v[j][1] += a.y * (1.0f / Y8_SCALE); v[j][2] += b2.x * (1.0f / Y8_SCALE); v[j][3] += b2.y * (1.0f / Y8_SCALE);
            v[j][4] += c.x * (1.0f / Y8_SCALE); v[j][5] += c.y * (1.0f / Y8_SCALE); v[j][6] += d.x * (1.0f / Y8_SCALE); v[j][7] += d.y * (1.0f / Y8_SCALE); } }
    float s = 0.f;
#pragma unroll
    for (int j = 0; j < 4; ++j)
#pragma unroll
        for (int i = 0; i < 8; ++i) s += v[j][i] * v[j][i];
    const float rstd = 1.0f / sqrtf(wave_sum(s) * (1.0f / DM) + NORM_EPS);
#pragma unroll
    for (int j = 0; j < 4; ++j) { const int c8 = 8 * (lane + 64 * j); const f32x4 g0 = *(const f32x4*)(gfin + c8), g1 = *(const f32x4*)(gfin + c8 + 4);
        f32x4* o = (f32x4*)(out + (size_t)m * DM + c8);
        o[0] = (f32x4){v[j][0] * rstd * g0.x, v[j][1] * rstd * g0.y, v[j][2] * rstd * g0.z, v[j][3] * rstd * g0.w};
        o[1] = (f32x4){v[j][4] * rstd * g1.x, v[j][5] * rstd * g1.y, v[j][6] * rstd * g1.z, v[j][7] * rstd * g1.w}; }
}

__global__ void __launch_bounds__(512, 2) fwd(Args args) {
    extern __shared__ __attribute__((aligned(16))) unsigned char lds_raw[];
    Frame F;
    F.lds = (LAS unsigned char*)lds_raw; F.MISC = (volatile LAS unsigned*)(F.lds + MISC_OFF);
    F.tid = threadIdx.x; F.lane = F.tid & 63; F.wave = __builtin_amdgcn_readfirstlane(F.tid >> 6);
    F.G = gridDim.x; { const int bx = blockIdx.x; F.vcu = (F.G % 8 == 0) ? (bx % 8) * (F.G / 8) + bx / 8 : bx; }
    F.ws = args.ws; F.ctl = (unsigned*)(args.ws + WS_CTL);
    if (F.tid < 64) F.MISC[F.tid] = 0u;
    __syncthreads();
    const int NH = (F.G > 4 * N_HELPERS) ? N_HELPERS : 0, GC0 = F.G - NH, bx = (int)blockIdx.x;
    (void)xcd_barrier_post(F.ctl + CW_BAR, F.MISC + 8, (unsigned)F.G);
#define BAR_A() grid_bar(F.ctl, F.MISC, 0, (unsigned)F.G)
#define REFRESH() do { int t_ = lane_id(); asm volatile("" : "+v"(t_)); F.lane = t_; F.tid = F.wave * 64 + t_; } while (0)
    unsigned char* ws = args.ws;
    const float* const w1f = args.in[23]; const float* const w2f = args.in[25];
    constexpr int CQ_HALF = CQ_W1 / 2;

    p0_prologue(F, args);
    REFRESH();
    convert_static(F, w1f, w2f, 0, CQ_HALF, F.vcu * 8 + F.wave, F.G * 8);
    BAR_A(); REFRESH();
    {
        const int gw = F.vcu * 8 + F.wave, NGW = F.G * 8;
        {
            pg8::ProbDense P{(const char*)(ws + WS_XN), (const char*)(ws + WS_WIN), DM, {}}; P.S.init(MROWS / 256, INW / 256, F.G, bx);
            EpiInProj E{(bf16*)(ws + WS_Z), args.in[4], (const f32x2*)(ws + WS_ROPE), (bf16*)(ws + WS_U2)};
            pg8::gemm_phase<pg8::ProbDense, EpiInProj, true>(F.lds, P, E, F.wave);
            REFRESH();
            { const int nwg = (MROWS / 256) * (INW / 256), r = nwg % F.G;
              if (r == 0) late_tables(F, args, bx, F.G); else if (bx >= r) late_tables(F, args, bx - r, F.G - r); }
        }
        BAR_A(); REFRESH();
        {
            const bf16* Z = (const bf16*)(ws + WS_Z);
            { AttnPre R; const int NU = NBATCH * NKVH * (SEQ / 64);
              if (F.vcu < NU) attn_load(F.tid, F.vcu, Z, R);
              for (int u = F.vcu; u < NU; u += F.G) attn_unit(F, u, (u + F.G < NU) ? u + F.G : -1, R, Z, args.in[5], (bf16*)(ws + WS_YA)); }
            for (int u = F.vcu; u < NG * NBATCH * 2; u += F.G) sloc_unit(F, u, (const bf16*)(ws + WS_U2), (const bf16*)(ws + WS_BMAT), ws + WS_SSMT, (bf16*)(ws + WS_SPREV));
        }
        BAR_A(); REFRESH();
        {
            for (int u = F.vcu; u < NG * NBATCH * 2; u += F.G)
                ssm_out_unit(F, u, (const bf16*)(ws + WS_U2), (const bf16*)(ws + WS_KTAB), (const bf16*)(ws + WS_CMAT), (const bf16*)(ws + WS_SPREV), args.in[13], (bf16*)(ws + WS_YS));
        }
        BAR_A(); REFRESH();
        {
            pg8::ProbDense P{(const char*)(ws + WS_YS), (const char*)(ws + WS_WGLU), SW, {}}; P.S.init(NTOK / 256, SW / 256, F.G, bx);
            EpiGlu E{(const bf16*)(ws + WS_YS), (bf16*)(ws + WS_YG), args.in[15]};
            pg8::gemm_phase<pg8::ProbDense, EpiGlu, true>(F.lds, P, E, F.wave);
        }
        BAR_A(); REFRESH();
        {
            const bf16* YA = (const bf16*)(ws + WS_YA); const bf16* YG = (const bf16*)(ws + WS_YG);
            if (gw < NTOK) {
                MixIn c0 = mix_load(gw, F.lane, YA, YG), c1 = mix_load(gw + NGW < NTOK ? gw + NGW : gw, F.lane, YA, YG);
#pragma unroll 1
                for (int m = gw; m < NTOK; m += 2 * NGW) {
                    const int mB = m + NGW, nA = m + 2 * NGW, nB = m + 3 * NGW;
                    const MixIn n0 = mix_load(nA < NTOK ? nA : m, F.lane, YA, YG), n1 = mix_load(nB < NTOK ? nB : m, F.lane, YA, YG);
                    mixnorm_row(m, F.lane, c0, args.in[16], args.in[17], (bf16*)(ws + WS_MIX));
                    if (mB < NTOK) mixnorm_row(mB, F.lane, c1, args.in[16], args.in[17], (bf16*)(ws + WS_MIX));
                    c0 = n0; c1 = n1;
                }
            }
        }
        BAR_A(); REFRESH();
        {
            pg8::ProbDense P{(const char*)(ws + WS_MIX), (const char*)(ws + WS_WOUT), DM, {}}; P.S.init(NTOK / 256, DM / 256, F.G, bx);
            EpiOutProj E{args.in[0], (bf16*)(ws + WS_H1), args.in[19]};
            pg8::gemm_phase<pg8::ProbDense, EpiOutProj, true>(F.lds, P, E, F.wave);
        }
        BAR_A(); REFRESH();
        {
            for (int rb = F.vcu; rb < NTOK / 64; rb += F.G)
                router_block(F, rb, (const bf16*)(ws + WS_H1), args.in[20], (const bf16*)(ws + WS_WRT), args.in[22], ws + WS_N2, (float*)(ws + WS_GATE), (int*)(ws + WS_LISTS), F.ctl + CW_COUNTS);
        }
    }
    BAR_A(); REFRESH();

    __syncthreads();
    if (F.tid < 64) { const unsigned cnt = F.tid < 32 ? (F.ctl + CW_COUNTS)[CNT_STRIDE * F.tid] : 0u; if (F.tid < 32) F.MISC[32 + F.tid] = cnt;
        const float nt = (float)((cnt + 255u) >> 8); const float t0 = wave_sum(F.tid < 16 ? nt : 0.f), t1 = wave_sum(F.tid >= 16 ? nt : 0.f);
        if (F.tid == 0) { F.MISC[20] = (unsigned)(int)t0; F.MISC[21] = (unsigned)(int)t1; } }
    __syncthreads();
#pragma unroll
    for (int half = 0; half < 2; ++half) {
        const int units_h = 16 * __builtin_amdgcn_readfirstlane((int)F.MISC[20 + half]);
        int GC = GC0;
        if (NH > 0 && units_h > 0) { const int R = (units_h + GC0 - 1) / GC0; const int need = ((units_h + R - 1) / R + 7) & ~7; GC = need < GC0 ? need : GC0; if (GC < F.G / 2) GC = F.G / 2; }
        const bool helper = bx >= GC;
        if (!helper) {
            pg8::ProbMoe P{(const char*)(ws + WS_N2), (const char*)(ws + WS_W1T), DM, 2, (size_t)4096 * 2048, {}, (const LAS unsigned*)(F.lds + TAB_OFF), (const LAS unsigned short*)(F.lds + IDS_OFF)};
            moe_setup(F, F.ctl + CW_COUNTS, (const int*)(ws + WS_LISTS), 16, P.S, half * 16, half * 16 + 16, GC, bx, args.in[24], 4096);
            EpiMoe1 E{ws + WS_ACT, args.in[24], P.tab, P.ids, F.lds + BIAS_OFF};
            pg8::gemm_phase<pg8::ProbMoe, EpiMoe1, true>(F.lds, P, E, F.wave);
            REFRESH();
        }
        {
            const int lo = (half == 0) ? CQ_HALF : CQ_W1, hi = lo + CQ_HALF;
            const int s0 = (NH > 0) ? (CQ_HALF * CQ_STATIC_PCT / 100) / (NH * 16) * (NH * 16) : 0;
            if (helper && s0 > 0) convert_static(F, w1f, w2f, lo, lo + s0, (bx - GC) * 8 + F.wave, (F.G - GC) * 8);
            convert_queue(F, w1f, w2f, lo + s0, hi, F.ctl + CW_QUEUE + 512 * half, (bx + F.wave) & 7);
        }
        BAR_A(); REFRESH();
    }
    {
        pg8::ProbMoe P{(const char*)(ws + WS_ACT), (const char*)(ws + WS_W2T), DFF, 0, (size_t)2048 * 2048, {}, (const LAS unsigned*)(F.lds + TAB_OFF), (const LAS unsigned short*)(F.lds + IDS_OFF)};
        moe_setup(F, F.ctl + CW_COUNTS, (const int*)(ws + WS_LISTS), 8, P.S, 0, NEXP, F.G, bx, args.in[26], DM);
        EpiMoe2 E{ws + WS_Y4, args.in[26], (const float*)(ws + WS_GATE), P.tab, P.ids, F.lds + BIAS_OFF};
        pg8::gemm_phase<pg8::ProbMoe, EpiMoe2, true>(F.lds, P, E, F.wave);
    }
    BAR_A(); REFRESH();
    {
        const int gw = F.vcu * 8 + F.wave, NGW = F.G * 8;
        const bf16* H1p = (const bf16*)(ws + WS_H1);
        if (gw < NTOK) {
            FinIn cur; final_load(gw, F.lane, H1p, ws + WS_Y4, cur);
#pragma unroll 1
            for (int m = gw; m < NTOK; m += NGW) {
                FinIn nxt; final_load(m + NGW < NTOK ? m + NGW : m, F.lane, H1p, ws + WS_Y4, nxt);
                final_row(m, F.lane, cur, args.in[27], args.out);
                cur = nxt;
            }
        }
    }
}

extern "C" void kernel_launch(void* const* d_in, const int* in_sizes, int n_in, void* d_out, int out_size, void* d_ws, size_t ws_size, hipStream_t stream) {
    static int grid = 0;
    if (grid == 0) {
        if (n_in != 28 || out_size != NTOK * DM || ws_size < WS_END) { fprintf(stderr, "kernel_launch: unexpected shapes: n_in %d out %d ws %zu (need %zu)\n", n_in, out_size, ws_size, (size_t)WS_END); grid = -1; return; }
        int dev = 0, cus = 0, per_cu = 0;
        if (hipGetDevice(&dev) != hipSuccess || hipDeviceGetAttribute(&cus, hipDeviceAttributeMultiprocessorCount, dev) != hipSuccess) { grid = -1; return; }
        if (hipFuncSetAttribute((const void*)fwd, hipFuncAttributeMaxDynamicSharedMemorySize, LDS_BYTES) != hipSuccess) { fprintf(stderr, "kernel_launch: hipFuncSetAttribute failed\n"); grid = -1; return; }
        if (hipOccupancyMaxActiveBlocksPerMultiprocessor(&per_cu, (const void*)fwd, 512, LDS_BYTES) != hipSuccess || per_cu < 1) fprintf(stderr, "kernel_launch: occupancy query reports %d\n", per_cu);
        (void)hipGetLastError();
        grid = cus;
    }
    if (grid < 0) return;
    (void)hipMemsetAsync((char*)d_ws + WS_CTL, 0, CTL_ZERO_BYTES, stream);
    Args a{};
    for (int i = 0; i < 28; ++i) a.in[i] = (const float*)d_in[i];
    a.out = (float*)d_out; a.ws = (unsigned char*)d_ws;
    a.ph_lo = 0; a.ph_hi = N_PHASES; a.li = 0;
    hipLaunchKernelGGL(fwd, dim3(grid), dim3(512), LDS_BYTES, stream, a);
}
```

```cpp
#include <hip/hip_runtime.h>
#include <cstdio>
#include <cstdint>

constexpr int N_PHASES = 11;

#define GAS __attribute__((address_space(1)))
#define LAS __attribute__((address_space(3)))
typedef unsigned short bf16;
typedef short bf16x8 __attribute__((ext_vector_type(8)));
typedef short s16x4 __attribute__((ext_vector_type(4)));
typedef short v4i16_t __attribute__((ext_vector_type(4)));
typedef float f32x2 __attribute__((ext_vector_type(2)));
typedef float f32x4 __attribute__((ext_vector_type(4)));
typedef float f32x16 __attribute__((ext_vector_type(16)));
typedef unsigned u32x2 __attribute__((ext_vector_type(2)));
typedef unsigned u32x4 __attribute__((ext_vector_type(4)));
typedef __bf16 bf16x2_t __attribute__((ext_vector_type(2)));

constexpr int DM = 2048, SEQ = 8192, NBATCH = 2, NTOK = NBATCH * SEQ, NMETA = 16;
constexpr int MROWS = NTOK + 256;
constexpr int INW = 2560, ZQ = 0, ZK = 1024, ZV = 1280, ZU = 1536;
constexpr int NQH = 16, NKVH = 4, HD = 64, AW = 1024, SW = 1024;
constexpr int NEXP = 32, DFF = 2048, NPAIR = NTOK * 4;
constexpr int NG = 64, GC = 16, NS = 64, CH = 64, NCH = SEQ / CH;
constexpr float NORM_EPS = 1e-5f;
constexpr int NPOS = NMETA + SEQ;

constexpr size_t MiB = 1u << 20;
constexpr size_t WS_CTL = 0, CTL_ZERO_BYTES = 1 * MiB;
constexpr size_t WS_ROPE = 1 * MiB;
constexpr size_t WS_SSMT = 4 * MiB;
constexpr size_t SSMT_A64 = 0, SSMT_ABAR = 32768, SSMT_BBAR = 65536, SSMT_SMETA = 65536 + 524288;
constexpr size_t WS_KTAB = 6 * MiB;
constexpr size_t WS_BMAT = 9 * MiB;
constexpr size_t WS_CMAT = 25 * MiB;
constexpr size_t WS_WRT = 41 * MiB;
constexpr size_t WS_WIN = 42 * MiB;
constexpr size_t WS_WGLU = 52 * MiB;
constexpr size_t WS_WOUT = 54 * MiB;
constexpr size_t WS_SPREV = 62 * MiB;
constexpr size_t WS_GATE = 70 * MiB;
constexpr size_t WS_RSI = 70 * MiB + 512 * 1024;
constexpr size_t WS_LISTS = 71 * MiB;
constexpr size_t WS_XN = 74 * MiB;
constexpr size_t WS_Z = 140 * MiB;
constexpr size_t WS_YA = 222 * MiB;
constexpr size_t WS_YS = 254 * MiB;
constexpr size_t WS_YG = 286 * MiB;
constexpr size_t WS_MIX = 318 * MiB;
constexpr size_t WS_H1 = 382 * MiB;
constexpr size_t WS_N2 = 510 * MiB;
constexpr size_t WS_W1T = 576 * MiB;
constexpr size_t WS_W2T = 1088 * MiB;
constexpr size_t WS_ACT = 1344 * MiB;
constexpr size_t WS_Y4 = 1600 * MiB;
constexpr size_t WS_U2 = 1856 * MiB;
constexpr size_t WS_END = 1908 * MiB;
constexpr int CW_COUNTS = 16384, CNT_STRIDE = 64;
constexpr int CW_QUEUE = 1024;
constexpr int CW_BAR = 4096;
#ifndef NHELP
#define NHELP 48
#endif
#ifndef CQ_STATIC_PCT
#define CQ_STATIC_PCT 0
#endif
constexpr int N_HELPERS = NHELP;

constexpr int RING_BYTES = 131072;
constexpr int IDS_OFF = RING_BYTES, IDS_UNITS = 20, IDS_BYTES = IDS_UNITS * 512;
constexpr int BIAS_OFF = IDS_OFF + IDS_BYTES, BIAS_UNITS = 16;
constexpr int TAB_OFF = BIAS_OFF + BIAS_UNITS * 1024;
constexpr int MISC_OFF = TAB_OFF + 1280;
constexpr int LDS_BYTES = 163840;
static_assert(MISC_OFF + 256 <= LDS_BYTES, "LDS map");

#define RLX_AGENT __ATOMIC_RELAXED, __HIP_MEMORY_SCOPE_AGENT
__device__ __forceinline__ unsigned cvtpk(float lo, float hi) { f32x2 v = {lo, hi}; bf16x2_t b = __builtin_convertvector(v, bf16x2_t); return __builtin_bit_cast(unsigned, b); }
__device__ __forceinline__ unsigned cvt4_fp8(float a, float b, float c, float d) { unsigned w; asm volatile("" : "=v"(w));   w = (unsigned)__builtin_amdgcn_cvt_pk_fp8_f32(a, b, (int)w, false); w = (unsigned)__builtin_amdgcn_cvt_pk_fp8_f32(c, d, (int)w, true); return w; }
__device__ __forceinline__ float bf2f(unsigned short h) { return __builtin_bit_cast(float, (unsigned)h << 16); }
__device__ __forceinline__ float bflo(unsigned w) { return __builtin_bit_cast(float, w << 16); }
__device__ __forceinline__ float bfhi(unsigned w) { return __builtin_bit_cast(float, w & 0xffff0000u); }
__device__ __forceinline__ float wave_sum(float v) {
#pragma unroll
    for (int o = 1; o < 64; o <<= 1) v += __shfl_xor(v, o);
    return v;
}
__device__ __forceinline__ int lane_id() { int r; asm volatile("v_mbcnt_lo_u32_b32 %0, -1, 0\n\tv_mbcnt_hi_u32_b32 %0, -1, %0" : "=v"(r)); return r; }
__device__ __forceinline__ float fast_exp2(float x) { return __builtin_amdgcn_exp2f(x); }
__device__ __forceinline__ float fast_rcp(float x) { return __builtin_amdgcn_rcpf(x); }
__device__ __forceinline__ float sigmoidf_fast(float x) { return fast_rcp(1.0f + fast_exp2(-1.4426950408889634f * x)); }
__device__ __forceinline__ void sincos_d(double x, double& s, double& c) {
    const double n = __builtin_rint(x * 0.15915494309189533577);
    double r = __builtin_fma(-n, 6.283185307179586232, x);
    r = __builtin_fma(-n, 2.4492935982947064e-16, r);
    const double r2 = r * r;
    double ts = r, ss = r, tc = 1.0, sc = 1.0;
#pragma unroll
    for (int k = 1; k <= 12; ++k) {
        tc *= -r2 / (double)((2 * k - 1) * (2 * k)); sc += tc;
        ts *= -r2 / (double)((2 * k) * (2 * k + 1)); ss += ts;
    }
    s = ss; c = sc;
}
__device__ __forceinline__ void sincos_f(float x, float& s, float& c) {
    const float rev = x * 0.15915494309189535f; const float fr = rev - __builtin_rintf(rev);
    s = __builtin_amdgcn_sinf(fr); c = __builtin_amdgcn_cosf(fr);
}

#define XB_TMO      128
#define XB_XCNT(j)  (256  + 64 * (j))
#define XB_XSUB(j)  (1280 + 64 * (j))
#define XB_XGEN(j)  (2304 + 64 * (j))
#define XB_TOP      3328
#define XB_TOPGEN   3392
#define XCD_BAR_WORDS 3456
#define XB_SPIN_CAP (1u << 22)
__device__ __forceinline__ unsigned xb_ld(unsigned* p)              { return __hip_atomic_load(p, __ATOMIC_RELAXED, __HIP_MEMORY_SCOPE_AGENT); }
__device__ __forceinline__ unsigned xb_add(unsigned* p, unsigned v) { return __hip_atomic_fetch_add(p, v, __ATOMIC_RELAXED, __HIP_MEMORY_SCOPE_AGENT); }
__device__ __forceinline__ unsigned xb_xcc_id() { return (unsigned)__builtin_amdgcn_s_getreg((3 << 11) | 20) & 0xFu; }
#define XB_SPIN(cond, bar) do { unsigned _sp = 0; while (cond) { __builtin_amdgcn_s_sleep(1); \
    if ((++_sp & 255u) == 0u) { if (xb_ld(&(bar)[XB_TMO])) break; if (_sp > XB_SPIN_CAP) { atomicAdd(&(bar)[XB_TMO], 1u); break; } } } } while (0)
struct XcdBarrier { unsigned* bar; unsigned x; volatile LAS unsigned* st; unsigned G; };
__device__ __forceinline__ XcdBarrier xcd_barrier_post(unsigned* bar, volatile LAS unsigned* st, unsigned G) {
    XcdBarrier b; b.bar = bar; b.x = xb_xcc_id(); b.st = st; b.G = G;
    if (threadIdx.x == 0) (void)xb_add(&bar[XB_XCNT(b.x)], 1u);
    return b;
}
__device__ __forceinline__ void xcd_barrier_complete(unsigned* bar, unsigned x, unsigned& nloc, unsigned& nx, const unsigned G) {
    unsigned sum, cnt, mine, sp = 0u;
    for (;;) {
        sum = 0u; cnt = 0u; mine = 0u;
#pragma unroll
        for (unsigned j = 0; j < 16; ++j) { const unsigned c = xb_ld(&bar[XB_XCNT(j)]); sum += c; cnt += (c > 0u) ? 1u : 0u; mine = (j == x) ? c : mine; }
        if (sum == G) break;
        __builtin_amdgcn_s_sleep(1);
        if ((++sp & 255u) == 0u) { if (xb_ld(&bar[XB_TMO])) break; if (sp > XB_SPIN_CAP) { atomicAdd(&bar[XB_TMO], 1u); break; } }
    }
    nloc = mine > 0u ? mine : 1u; nx = cnt > 0u ? cnt : 1u;
}
template <bool KEEP32>
__device__ __forceinline__ void xcd_barrier_impl(const XcdBarrier& b) {
    if constexpr (KEEP32) { asm volatile("s_waitcnt vmcnt(32)" ::: "memory"); __builtin_amdgcn_s_barrier(); asm volatile("" ::: "memory"); }
    else { asm volatile("s_waitcnt vmcnt(0)" ::: "memory"); __syncthreads(); }
    if (threadIdx.x == 0) {
        unsigned* bar = b.bar;
        __builtin_amdgcn_s_waitcnt(0);
        unsigned nloc = b.st[0], nx = b.st[1];
        if (nloc == 0u) { xcd_barrier_complete(bar, b.x, nloc, nx, b.G); b.st[0] = nloc; b.st[1] = nx; }
        const unsigned old = xb_add(&bar[XB_XSUB(b.x)], 1u);
        const unsigned gen = old / nloc;
        if (old + 1u == (gen + 1u) * nloc) {
            __builtin_amdgcn_fence(__ATOMIC_RELEASE, "agent");
            asm volatile("s_waitcnt vmcnt(0)" ::: "memory");
            const unsigned og = xb_add(&bar[XB_TOP], 1u);
            const unsigned tg = og / nx;
            if (og + 1u == (tg + 1u) * nx) xb_add(&bar[XB_TOPGEN], 1u);
            else XB_SPIN(xb_ld(&bar[XB_TOPGEN]) == tg, bar);
            __builtin_amdgcn_fence(__ATOMIC_ACQUIRE, "agent");
            asm volatile("s_waitcnt vmcnt(0)" ::: "memory");
        } else {
            XB_SPIN(xb_ld(&bar[XB_TOPGEN]) == gen, bar);
            __builtin_amdgcn_fence(__ATOMIC_ACQUIRE, "agent");
            asm volatile("s_waitcnt vmcnt(0)" ::: "memory");
        }
    }
    if constexpr (KEEP32) { asm volatile("" ::: "memory"); __builtin_amdgcn_s_barrier(); asm volatile("" ::: "memory"); }
    else __syncthreads();
}

template <bool KEEP32 = false>
__device__ __forceinline__ void grid_bar(unsigned* ctl, volatile LAS unsigned* MISC, int which, unsigned G) {
    XcdBarrier b; b.bar = ctl + CW_BAR + which * XCD_BAR_WORDS; b.x = xb_xcc_id(); b.st = MISC + 8 + 2 * which; b.G = G;
    xcd_barrier_impl<KEEP32>(b);
}
namespace pg8 {
constexpr int BM = 256, BK = 64, HALF = 128, HTB = HALF * BK * 2, STAGE_BYTES = 8 * HTB, NXCD = 8, WGM = 8;
__host__ __device__ __forceinline__ int lds_byte(int r, int c) { const int st = (r >> 4) * 2 + (c >> 5), rr = r & 15, cc = c & 31, ob = rr * 64 + cc * 2; return st * 1024 + (ob ^ (((ob >> 9) & 1) << 5)); }
__host__ __device__ __forceinline__ void stage_rc(int b, int& R, int& C) { const int st = b / 1024, sb = b % 1024, swz = sb ^ (((sb >> 9) & 1) << 5); R = (st >> 1) * 16 + swz / 64; C = (st & 1) * 32 + (swz % 64) / 2; }
__host__ __device__ __forceinline__ int perm32(int rho) { const int n = rho >> 4, i = rho & 15; return 8 * (i >> 2) + 4 * n + (i & 3); }
typedef int i32x4 __attribute__((ext_vector_type(4)));
typedef int i32x8 __attribute__((ext_vector_type(8)));
typedef i32x8 Frag;
template <int ESZ> __device__ __forceinline__ Frag ldfrag(const LAS unsigned char* p) { const i32x4 x = *(const LAS i32x4*)p, y = *(const LAS i32x4*)(p + 1024); return __builtin_shufflevector(x, y, 0, 1, 2, 3, 4, 5, 6, 7); }
__device__ __forceinline__ bf16x8 flo(Frag f) { return __builtin_bit_cast(bf16x8, __builtin_shufflevector(f, f, 0, 1, 2, 3)); }
__device__ __forceinline__ bf16x8 fhi(Frag f) { return __builtin_bit_cast(bf16x8, __builtin_shufflevector(f, f, 4, 5, 6, 7)); }
struct Unit { int pm, pn, ord; };
struct StaticOrder {
    int nM, nN, nwg, G, c;
    __device__ void init(int nM_, int nN_, int G_, int c_) { nM = nM_; nN = nN_; nwg = nM * nN; G = G_; c = c_; }
    __device__ bool next(int i, Unit& u) const {
        const int L = i * G + c; if (L >= nwg) return false;
        int wgid = L; { const int q = nwg / NXCD, r = nwg % NXCD, xcd = wgid % NXCD, off = wgid / NXCD; wgid = (xcd < r ? xcd * (q + 1) : r * (q + 1) + (xcd - r) * q) + off; }
        const int nig = WGM * nN, gid = wgid / nig, fm = gid * WGM, gsz = (nM - fm) < WGM ? (nM - fm) : WGM;
        u.pm = fm + ((wgid % nig) % gsz); u.pn = (wgid % nig) / gsz; u.ord = i; return true;
    }
};
template <class Prob, class Epi, bool ALIGN_EPI>
__device__ __forceinline__ void gemm_phase(LAS unsigned char* lds, const Prob& P, const Epi& E, const int wid  ) {
    int lane = lane_id(); asm volatile("" : "+v"(lane));
    const int tid = wid * 64 + lane; const int wr = wid >> 2, wc = wid & 3, fr = lane & 15, fq = lane >> 4;
    constexpr int ESZ = Prob::ESZ; const int K = P.K, nt = K * ESZ / 128;
    unsigned voffB[2];
#pragma unroll
    for (int i = 0; i < 2; ++i) { int R, C; stage_rc(tid * 16 + i * 8192, R, C); int Rb;
        if constexpr (Epi::PERM == 2) Rb = (R >> 5) * 64 + ((R >> 2) & 3) * 16 + ((R >> 4) & 1) * 4 + (R & 3);
        else if constexpr (Epi::PERM == 3) Rb = (R >> 5) * 64 + ((R >> 2) & 3) * 16 + (R & 3) * 2 + ((R >> 4) & 1);
        else Rb = Epi::PERM ? ((R & ~31) + perm32(R & 31)) : R;
        voffB[i] = (unsigned)(Rb * K * ESZ + C * 2); }
    const size_t kstep = (size_t)(BK * 2);
    const size_t hstepB = (size_t)(Epi::PERM >= 2 ? 8 : HALF) * K * ESZ;
    const unsigned ldsw0 = (unsigned)wid * 1024u; const unsigned ldsw = ldsw0;
    const LAS unsigned char* apt = lds + lds_byte(wr * 64 + fr, fq * 8); const LAS unsigned char* bpt = lds + 4 * HTB + lds_byte(wc * 32 + fr, fq * 8);
    asm volatile("" : "+v"(apt), "+v"(bpt));
#define PG8_SA(b, h) (((b) * 2 + (h)) * HTB)
#define PG8_SB(b, h) ((4 + (b) * 2 + (h)) * HTB)
#define PG8_STAGE(bufoff, rs, soff, voff) do { _Pragma("unroll") for (int _i = 0; _i < 2; ++_i) \
        __builtin_amdgcn_raw_ptr_buffer_load_lds((rs), (LAS void*)(lds + (bufoff) + ldsw + _i * 8192), 16, (int)(voff)[_i], (int)(soff), 0, 0); } while (0)
#define PG8_LDA(dst, b, h) do { _Pragma("unroll") for (int m = 0; m < 4; ++m) dst[m] = ldfrag<ESZ>(apt + PG8_SA(b, h) + m * 2048); } while (0)
#define PG8_LDB(dst, b, h) do { _Pragma("unroll") for (int n = 0; n < 2; ++n) dst[n] = ldfrag<ESZ>(bpt + (PG8_SB(b, h) - 4 * HTB) + n * 2048); } while (0)
#define PG8_MMA(ai, bj, At, Bt) do { __builtin_amdgcn_s_setprio(1); _Pragma("unroll") for (int m = 0; m < 4; ++m) _Pragma("unroll") for (int n = 0; n < 2; ++n) { \
        if constexpr (ESZ == 2) { acc[ai][bj][m][n] = __builtin_amdgcn_mfma_f32_16x16x32_bf16(flo(Bt[n]), flo(At[m]), acc[ai][bj][m][n], 0, 0, 0); \
                                  acc[ai][bj][m][n] = __builtin_amdgcn_mfma_f32_16x16x32_bf16(fhi(Bt[n]), fhi(At[m]), acc[ai][bj][m][n], 0, 0, 0); } \
        else acc[ai][bj][m][n] = __builtin_amdgcn_mfma_scale_f32_16x16x128_f8f6f4(Bt[n], At[m], acc[ai][bj][m][n], 0, 0, 0, Prob::SCALE_B, 0, Prob::SCALE_A); } \
        __builtin_amdgcn_s_setprio(0); } while (0)
#define PG8_WAIT_V(n) asm volatile("s_waitcnt vmcnt(" #n ")" ::: "memory")
#define PG8_WAIT_L(n) asm volatile("s_waitcnt lgkmcnt(" #n ")" ::: "memory")
#define PG8_BAR __builtin_amdgcn_s_barrier()
#define PG8_SCHED __builtin_amdgcn_sched_barrier(0)
    Unit cur, nxt;
    if (!P.next(0, cur)) return;
    f32x4 acc[2][2][4][2];
    E.init(acc, cur, wr, wc, fr, fq);
    Frag At[4], B0[2], B1[2];
    unsigned X[2][2], c1[2];
    P.a_off(cur, wid, X); c1[0] = X[1][0]; c1[1] = X[1][1];
    const __amdgpu_buffer_rsrc_t rsA = P.a_rsrc(), rsB = P.b_rsrc();
    unsigned cB = P.b_off(cur);
    const unsigned hB = (unsigned)hstepB, ks = (unsigned)kstep;
    PG8_STAGE(PG8_SB(0, 0), rsB, cB, voffB); PG8_STAGE(PG8_SB(0, 1), rsB, cB + hB, voffB); PG8_STAGE(PG8_SA(0, 0), rsA, 0u, X[0]); PG8_STAGE(PG8_SA(0, 1), rsA, 0u, X[1]);
    if (wr == 1) PG8_BAR;
    PG8_WAIT_V(2); PG8_BAR;
    PG8_STAGE(PG8_SB(1, 0), rsB, cB + ks, voffB); PG8_STAGE(PG8_SA(1, 0), rsA, ks, X[0]); PG8_STAGE(PG8_SB(1, 1), rsB, cB + hB + ks, voffB);
    PG8_WAIT_V(6); PG8_BAR;
    for (;;) {
        bool has_next = false; unsigned nB = cB;
        for (int t = 0; t < nt; t += 2) {
            const bool last = (t == nt - 2);
            unsigned ldsw = ldsw0; asm volatile("" : "+s"(ldsw));
            if (last) { has_next = P.next(cur.ord + 1, nxt); if (has_next) { P.a_off(nxt, wid, X); nB = P.b_off(nxt); } }
            const unsigned a1 = (unsigned)(t + 1) * ks;
            const unsigned a2 = last ? 0u : (unsigned)(t + 2) * ks, b2 = last ? nB : cB + (unsigned)(t + 2) * ks;
            const unsigned a3 = a2 + ks, b3 = b2 + ks;
            PG8_LDB(B0, 0, 0); PG8_LDB(B1, 0, 1); PG8_SCHED; PG8_LDA(At, 0, 0); PG8_STAGE(PG8_SA(1, 1), rsA, a1, c1);
            PG8_WAIT_V(8); PG8_WAIT_L(0); PG8_BAR; PG8_MMA(0, 0, At, B0); PG8_MMA(0, 1, At, B1); PG8_BAR; PG8_SCHED;
            PG8_LDA(At, 0, 1); PG8_STAGE(PG8_SB(0, 0), rsB, b2, voffB); PG8_STAGE(PG8_SB(0, 1), rsB, b2 + hB, voffB); PG8_STAGE(PG8_SA(0, 0), rsA, a2, X[0]);
            PG8_WAIT_V(8); PG8_WAIT_L(0); PG8_BAR; PG8_MMA(1, 0, At, B0); PG8_MMA(1, 1, At, B1); PG8_BAR; PG8_SCHED;
            PG8_LDB(B0, 1, 0); PG8_LDB(B1, 1, 1); PG8_SCHED; PG8_LDA(At, 1, 0); PG8_STAGE(PG8_SA(0, 1), rsA, a2, X[1]);
            PG8_WAIT_V(8); PG8_WAIT_L(0); PG8_BAR; PG8_MMA(0, 0, At, B0); PG8_MMA(0, 1, At, B1); PG8_BAR; PG8_SCHED;
            PG8_LDA(At, 1, 1); PG8_STAGE(PG8_SB(1, 0), rsB, b3, voffB); PG8_STAGE(PG8_SB(1, 1), rsB, b3 + hB, voffB); PG8_STAGE(PG8_SA(1, 0), rsA, a3, X[0]);
            PG8_WAIT_V(8); PG8_WAIT_L(0); PG8_BAR; PG8_MMA(1, 0, At, B0); PG8_MMA(1, 1, At, B1); PG8_BAR; PG8_SCHED;
        }
        c1[0] = X[1][0]; c1[1] = X[1][1]; cB = nB;
        if constexpr (ALIGN_EPI) { if (wr == 0) PG8_BAR; }
        { int t_ = lane_id(); asm volatile("" : "+v"(t_));
          E(acc, cur, wr, wc, t_ & 15, (t_ >> 4) & 3); }
        if (!has_next) break;
        { int t_ = lane_id(); asm volatile("" : "+v"(t_)); E.init(acc, nxt, wr, wc, t_ & 15, (t_ >> 4) & 3); }
        cur = nxt;
        if constexpr (ALIGN_EPI) { if (wr == 1) PG8_BAR; }
    }
    PG8_WAIT_V(0);
    if constexpr (!ALIGN_EPI) { if (wr == 0) PG8_BAR; }
    PG8_BAR;
#undef PG8_SA
#undef PG8_SB
#undef PG8_STAGE
#undef PG8_LDA
#undef PG8_LDB
#undef PG8_MMA
#undef PG8_WAIT_V
#undef PG8_WAIT_L
#undef PG8_BAR
#undef PG8_SCHED
}

struct ProbDense {
    static constexpr int ESZ = 2, SCALE_A = 0x7f7f7f7f, SCALE_B = 0x7f7f7f7f;
    const char* A; const char* Bt; int K; StaticOrder S;
    __device__ __forceinline__ bool next(int i, Unit& u) const { return S.next(i, u); }
    __device__ __forceinline__ __amdgpu_buffer_rsrc_t a_rsrc() const { return __builtin_amdgcn_make_buffer_rsrc((void*)A, 0, 0x7ffffff0, 0x00020000); }
    __device__ __forceinline__ __amdgpu_buffer_rsrc_t b_rsrc() const { return __builtin_amdgcn_make_buffer_rsrc((void*)Bt, 0, 0x7ffffff0, 0x00020000); }
    __device__ __forceinline__ unsigned b_off(const Unit& u) const { return (unsigned)u.pn * (unsigned)(BM * 2) * (unsigned)K; }
    __device__ __forceinline__ void a_off(const Unit& u, int wid, unsigned (&off)[2][2]) const {
        int tid = lane_id(); asm volatile("" : "+v"(tid)); tid += wid * 64;
#pragma unroll
        for (int i = 0; i < 2; ++i) { int R, C; stage_rc(tid * 16 + i * 8192, R, C);
#pragma unroll
            for (int h = 0; h < 2; ++h) off[h][i] = (unsigned)((u.pm * BM + h * HALF + R) * K + C) * 2u; }
    }
};
struct ProbMoe {
    static constexpr int ESZ = 1, SCALE_A = 0x7c7c7c7c, SCALE_B = 0x7c7c7c7c;
    const char* A; const char* Bt; int K; int id_shift; size_t b_estride; StaticOrder S; const LAS unsigned* tab; const LAS unsigned short* ids;
    __device__ __forceinline__ bool next(int i, Unit& u) const { return S.next(i, u); }
    __device__ __forceinline__ __amdgpu_buffer_rsrc_t a_rsrc() const { return __builtin_amdgcn_make_buffer_rsrc((void*)A, 0, 0x7ffffff0, 0x00020000); }
    __device__ __forceinline__ __amdgpu_buffer_rsrc_t b_rsrc() const { return __builtin_amdgcn_make_buffer_rsrc((void*)Bt, 0, 0x7ffffff0, 0x00020000); }
    __device__ __forceinline__ unsigned b_off(const Unit& u) const { const unsigned e = (unsigned)__builtin_amdgcn_readfirstlane((int)tab[u.pm]) & 31u; return e * (unsigned)b_estride + (unsigned)u.pn * (unsigned)BM * (unsigned)K; }
    __device__ __forceinline__ void a_off(const Unit& u, int wid, unsigned (&off)[2][2]) const {
        int tid = lane_id(); asm volatile("" : "+v"(tid)); tid += wid * 64;
        const LAS unsigned short* id = ids + (u.ord % IDS_UNITS) * 256;
#pragma unroll
        for (int i = 0; i < 2; ++i) { int R, C; stage_rc(tid * 16 + i * 8192, R, C);
#pragma unroll
            for (int h = 0; h < 2; ++h) off[h][i] = ((unsigned)id[h * HALF + R] >> id_shift) * (unsigned)K + (unsigned)C * 2u; }
    }
};
}

struct Args { const float* in[28]; float* out; unsigned char* ws; int ph_lo, ph_hi, li, pad; };
struct Frame {
    LAS unsigned char* lds; volatile LAS unsigned* MISC; unsigned* ctl; unsigned char* ws;
    int tid, lane, wave, vcu, G;
};

template <bool PERMQK>
__device__ __forceinline__ void tr_item(const float* W, int K, int N, bf16* WT, int k0, int n0, LAS unsigned* scr, int lane) {
    f32x4 v[16];
    const int a = lane & 15, q = lane >> 4;
#pragma unroll
    for (int j = 0; j < 8; ++j) {
        const int k = 2 * q + 8 * j;
        v[2 * j] = *(const f32x4*)(W + (size_t)(k0 + k) * N + n0 + 4 * a);
        v[2 * j + 1] = *(const f32x4*)(W + (size_t)(k0 + k + 1) * N + n0 + 4 * a);
    }
#pragma unroll
    for (int j = 0; j < 8; ++j)
#pragma unroll
        for (int i = 0; i < 4; ++i) scr[(4 * a + i) * 33 + q + 4 * j] = cvtpk(v[2 * j][i], v[2 * j + 1][i]);
    asm volatile("s_waitcnt lgkmcnt(0)" ::: "memory");
    const int c = lane & 7;
#pragma unroll
    for (int jj = 0; jj < 8; ++jj) {
        const int nl = (lane >> 3) + 8 * jj; const LAS unsigned* s = scr + nl * 33 + 4 * c;
        u32x4 o; o.x = s[0]; o.y = s[1]; o.z = s[2]; o.w = s[3];
        int n = n0 + nl;
        int dr = n;
        if (PERMQK) { if (n < ZV) { const int hb = n & ~63, d = n & 63; const int pos = 8 * ((d & 31) >> 2) + (d & 3) + 4 * (d >> 5); dr = hb + pos; } }
        *(u32x4*)(WT + (size_t)dr * K + k0 + 8 * c) = o;
    }
    asm volatile("s_waitcnt lgkmcnt(0)" ::: "memory");
}
constexpr float Y8_SCALE = 16.0f;
constexpr float W8_SCALE = 8.0f, A8_SCALE = 8.0f;
__device__ __forceinline__ void tr8_load(const float* W, int N, int k0, int n0, int lane, f32x4 (&v)[16]) {
    const int a = lane & 15, q = lane >> 4;
    const unsigned voff = (unsigned)((4 * q * N + 4 * a) * 4);
    const char* base = (const char*)(W + (size_t)k0 * N + n0);
#pragma unroll
    for (int j = 0; j < 4; ++j)
#pragma unroll
        for (int r = 0; r < 4; ++r) v[4 * j + r] = *(const f32x4*)(base + (size_t)(16 * j + r) * N * 4 + voff);
}
__device__ __forceinline__ void tr8_store(const f32x4 (&v)[16], unsigned char* WT, int K, int k0, int n0, LAS unsigned* scr, int lane) {
    const int a = lane & 15, q = lane >> 4;
#pragma unroll
    for (int j = 0; j < 4; ++j)
#pragma unroll
        for (int i = 0; i < 4; ++i) scr[(4 * a + i) * 17 + q + 4 * j] = cvt4_fp8(v[4 * j][i] * W8_SCALE, v[4 * j + 1][i] * W8_SCALE, v[4 * j + 2][i] * W8_SCALE, v[4 * j + 3][i] * W8_SCALE);
    asm volatile("s_waitcnt lgkmcnt(0)" ::: "memory");
    const int c = lane & 3;
    const unsigned voff = (unsigned)((lane >> 2) * K + 16 * c);
    unsigned char* base = WT + (size_t)n0 * K + k0;
#pragma unroll
    for (int jj = 0; jj < 4; ++jj) {
        const int nl = (lane >> 2) + 16 * jj; const LAS unsigned* sp = scr + nl * 17 + 4 * c;
        u32x4 o; o.x = sp[0]; o.y = sp[1]; o.z = sp[2]; o.w = sp[3];
        *(u32x4*)(base + (size_t)(16 * jj) * K + voff) = o;
    }
    asm volatile("s_waitcnt lgkmcnt(0)" ::: "memory");
}
struct SsmP { float zre, zim, are, aim, cre, cim; };
__device__ __forceinline__ SsmP ssm_param(const float* a_re, const float* a_im, const float* log_dt, int g, int p) {
    SsmP r; const float dt = __expf(log_dt[g]); const float lre = fminf(a_re[g * NS + p], -1e-4f), lim = a_im[g * NS + p];
    r.zre = lre * dt; r.zim = lim * dt;
    const float mag = __expf(r.zre); float s, c; sincos_f(r.zim, s, c);
    r.are = mag * c; r.aim = mag * s;
    const float den = lre * lre + lim * lim, nre = r.are - 1.0f, nim = r.aim;
    r.cre = (nre * lre + nim * lim) / den; r.cim = (nim * lre - nre * lim) / den;
    return r;
}
__device__ __forceinline__ void ssm_pow(const SsmP& q, int d, float& pre, float& pim) {
    const float mag = __expf(q.zre * (float)d); float s, c; sincos_f(q.zim * (float)d, s, c); pre = mag * c; pim = mag * s;
}

constexpr int CQ_W1 = 32 * 32 * 64, CQ_TOTAL = CQ_W1 + 32 * 32 * 32;
struct CqItem { const float* src; unsigned char* dst; int N; };
__device__ __forceinline__ CqItem cq_decode(const float* w1, const float* w2, unsigned char* ws, int it) {
    CqItem c;
    if (it < CQ_W1) { const int e = it >> 11, j = it & 2047, kb = 2 * (j >> 7) + (j & 1), nb = 2 * ((j >> 2) & 31) + ((j >> 1) & 1); c.N = 4096; c.src = w1 + ((size_t)e * 2048 + kb * 64) * 4096 + nb * 64; c.dst = ws + WS_W1T + ((size_t)e * 4096 + nb * 64) * 2048 + kb * 64; }
    else { const int i2 = it - CQ_W1; const int e = i2 >> 10, j = i2 & 1023, kb = 2 * (j >> 6) + (j & 1), nb = 2 * ((j >> 2) & 15) + ((j >> 1) & 1); c.N = 2048; c.src = w2 + ((size_t)e * 2048 + kb * 64) * 2048 + nb * 64; c.dst = ws + WS_W2T + ((size_t)e * 2048 + nb * 64) * 2048 + kb * 64; }
    return c;
}
__device__ __forceinline__ void convert_static(Frame& F, const float* w1, const float* w2, int lo, int hi, int w, int NW) {
    LAS unsigned* scr = (LAS unsigned*)(F.lds + F.wave * 8704);
    f32x4 va[16], vb[16];
    if ((hi - lo) % (2 * NW) == 0 && hi > lo) {
        const int last = lo + w + ((hi - lo) / NW - 1) * NW;
        { const CqItem c = cq_decode(w1, w2, F.ws, lo + w); tr8_load(c.src, c.N, 0, 0, F.lane, va); }
        for (int it = lo + w; it < hi; it += 2 * NW) {
            const int it2 = it + NW; int it3 = it2 + NW; it3 = it3 < hi ? it3 : last;
            const CqItem c0 = cq_decode(w1, w2, F.ws, it), c2 = cq_decode(w1, w2, F.ws, it2), c3 = cq_decode(w1, w2, F.ws, it3);
            tr8_load(c2.src, c2.N, 0, 0, F.lane, vb); __builtin_amdgcn_sched_barrier(0);
            tr8_store(va, c0.dst, 2048, 0, 0, scr, F.lane); __builtin_amdgcn_sched_barrier(0);
            tr8_load(c3.src, c3.N, 0, 0, F.lane, va); __builtin_amdgcn_sched_barrier(0);
            tr8_store(vb, c2.dst, 2048, 0, 0, scr, F.lane); __builtin_amdgcn_sched_barrier(0);
        }
    } else {
        for (int it = lo + w; it < hi; it += NW) { const CqItem c = cq_decode(w1, w2, F.ws, it); tr8_load(c.src, c.N, 0, 0, F.lane, va); tr8_store(va, c.dst, 2048, 0, 0, scr, F.lane); }
    }
}
constexpr int CQ_SUB = 8;
__device__ __forceinline__ void convert_queue(Frame& F, const float* w1, const float* w2, int lo, int hi, unsigned* q, int first) {
    LAS unsigned* scr = (LAS unsigned*)(F.lds + F.wave * 8704);
    f32x4 va[16], vb[16];
    const unsigned nsub = (unsigned)(hi - lo) / CQ_SUB;
    unsigned live;
    { unsigned v = 0xffffffffu; if (F.lane < CQ_SUB) v = __hip_atomic_load(q + 64 * F.lane, RLX_AGENT); live = (unsigned)__builtin_amdgcn_ballot_w64(v < nsub); }
    for (int jj = 0; jj < CQ_SUB; ++jj) {
        const int j = (first + jj) & (CQ_SUB - 1);
        if (!((live >> j) & 1u)) continue;
        unsigned* qj = q + 64 * j; const int base = lo + j * (int)nsub;
        unsigned t = 0u;
        if (F.lane == 0) t = __hip_atomic_fetch_add(qj, 4u, RLX_AGENT);
        t = (unsigned)__builtin_amdgcn_readfirstlane((int)t);
        while (t < nsub) {
            const int it = base + (int)t;
            unsigned tn = 0u;
            if (F.lane == 0) tn = __hip_atomic_fetch_add(qj, 4u, RLX_AGENT);
            const CqItem c0 = cq_decode(w1, w2, F.ws, it), c1 = cq_decode(w1, w2, F.ws, it + 1), c2 = cq_decode(w1, w2, F.ws, it + 2), c3 = cq_decode(w1, w2, F.ws, it + 3);
            tr8_load(c0.src, c0.N, 0, 0, F.lane, va); tr8_load(c1.src, c1.N, 0, 0, F.lane, vb); __builtin_amdgcn_sched_barrier(0);
            tr8_store(va, c0.dst, 2048, 0, 0, scr, F.lane); __builtin_amdgcn_sched_barrier(0);
            tr8_load(c2.src, c2.N, 0, 0, F.lane, va); __builtin_amdgcn_sched_barrier(0);
            tr8_store(vb, c1.dst, 2048, 0, 0, scr, F.lane); __builtin_amdgcn_sched_barrier(0);
            tr8_load(c3.src, c3.N, 0, 0, F.lane, vb); __builtin_amdgcn_sched_barrier(0);
            tr8_store(va, c2.dst, 2048, 0, 0, scr, F.lane); __builtin_amdgcn_sched_barrier(0);
            tr8_store(vb, c3.dst, 2048, 0, 0, scr, F.lane); __builtin_amdgcn_sched_barrier(0);
            t = (unsigned)__builtin_amdgcn_readfirstlane((int)tn);
        }
    }
}

__device__ __forceinline__ void p0_prologue(Frame& F, const Args& A) {
    const int gw = F.vcu * 8 + F.wave, NGW = F.G * 8;
    const int lane = F.lane;
    unsigned char* ws = F.ws;
    LAS unsigned* scr = (LAS unsigned*)(F.lds + F.wave * 8704);
    {
        for (int it = gw; it < 32 * 40; it += NGW) { const int kb = it / 40, nb = it % 40; tr_item<true>(A.in[3], 2048, INW, (bf16*)(ws + WS_WIN), kb * 64, nb * 64, scr, lane); }
    }
    {
        const float* x = A.in[0]; const float* meta = A.in[1]; const float* gm = A.in[2]; bf16* XN = (bf16*)(ws + WS_XN);
        for (int m = gw; m < MROWS; m += NGW) {
            u32x2* o8 = (u32x2*)(XN + (size_t)m * DM) + lane;
            if (m >= NTOK + NMETA) {
#pragma unroll
                for (int j = 0; j < 8; ++j) o8[64 * j] = (u32x2){0u, 0u};
                continue; }
            const f32x4* xr = (const f32x4*)(m < NTOK ? x + (size_t)m * DM : meta + (size_t)(m - NTOK) * DM) + lane;
            f32x4 v[8]; float s = 0.f;
#pragma unroll
            for (int j = 0; j < 8; ++j) { v[j] = xr[64 * j]; s += (v[j].x * v[j].x + v[j].y * v[j].y) + (v[j].z * v[j].z + v[j].w * v[j].w); }
            const float ms_ = wave_sum(s) * (1.0f / DM) + NORM_EPS; const float rstd = 1.0f / sqrtf(ms_);
            if (m < NTOK && lane == 0) ((float*)(ws + WS_RSI))[m] = sqrtf(ms_);
#pragma unroll
            for (int j = 0; j < 8; ++j) { const f32x4 g = ((const f32x4*)gm)[lane + 64 * j]; o8[64 * j] = (u32x2){cvtpk(v[j].x * rstd * g.x, v[j].y * rstd * g.y), cvtpk(v[j].z * rstd * g.z, v[j].w * rstd * g.w)}; }
        }
    }
    const int gt = gw * 64 + lane, NGT = NGW * 64;
    {
        f32x2* T = (f32x2*)(ws + WS_ROPE);
        for (int i = gt; i < NPOS * 32; i += NGT) { const int pos = i >> 5, d = i & 31;
            const float invf = exp2f(-(float)d * (13.287712379549449f / 32.0f)); const float ang = (float)pos * invf;
            double s, c; sincos_d((double)ang, s, c); T[i] = (f32x2){(float)c, (float)s}; }
    }
    {
        const float* wr = A.in[21]; bf16* WT = (bf16*)(ws + WS_WRT);
        for (int i = gt; i < 32 * 2048; i += NGT) { const int e = i >> 11, k = i & 2047; WT[i] = (bf16)(cvtpk(wr[k * 32 + e], 0.f) & 0xffffu); }
    }
    const float* a_re = A.in[6]; const float* a_im = A.in[7]; const float* log_dt = A.in[8];
    const float* b_re = A.in[9]; const float* b_im = A.in[10]; const float* c_re = A.in[11]; const float* c_im = A.in[12];
    {
        f32x2* A64 = (f32x2*)(ws + WS_SSMT + SSMT_A64); f32x2* AB = (f32x2*)(ws + WS_SSMT + SSMT_ABAR); f32x2* BB = (f32x2*)(ws + WS_SSMT + SSMT_BBAR);
        for (int i = gt; i < NG * NS; i += NGT) { const int g = i >> 6, p = i & 63;
            const double dt = exp((double)log_dt[g]); const double lre = fmin((double)a_re[i], -1e-4), lim = (double)a_im[i];
            const double zre = lre * dt, zim = lim * dt; double s, c; sincos_d(zim, s, c); const double mag = exp(zre);
            const double are = mag * c, aim = mag * s; const double den = lre * lre + lim * lim, nre = are - 1.0, nim = aim;
            const double cre = (nre * lre + nim * lim) / den, cim = (nim * lre - nre * lim) / den;
            double s64, c64; sincos_d(zim * 64.0, s64, c64); const double m64 = exp(zre * 64.0);
            A64[i] = (f32x2){(float)(m64 * c64), (float)(m64 * s64)}; AB[i] = (f32x2){(float)are, (float)aim};
#pragma unroll
            for (int cc = 0; cc < GC; ++cc) { const double br = (double)b_re[(size_t)i * GC + cc], bi = (double)b_im[(size_t)i * GC + cc];
                BB[(size_t)i * GC + cc] = (f32x2){(float)(cre * br - cim * bi), (float)(cre * bi + cim * br)}; }
        }
    }
}

__device__ __forceinline__ void late_tables(Frame& F, const Args& A, int idx, int cnt) {
    unsigned char* ws = F.ws; const int lane = F.lane;
    LAS unsigned* scr = (LAS unsigned*)(F.lds + F.wave * 8704);
    const int gw = idx * 8 + F.wave, NGW = cnt * 8;
    __syncthreads();
    for (int it = gw; it < 32 * 32; it += NGW) { const int kb = it >> 5, nb = it & 31; tr_item<false>(A.in[18], 2048, 2048, (bf16*)(ws + WS_WOUT), kb * 64, nb * 64, scr, lane); }
    for (int it = gw; it < 16 * 16; it += NGW) { const int kb = it >> 4, nb = it & 15; tr_item<false>(A.in[14], 1024, 1024, (bf16*)(ws + WS_WGLU), kb * 64, nb * 64, scr, lane); }
    const float* a_re = A.in[6]; const float* a_im = A.in[7]; const float* log_dt = A.in[8];
    const float* b_re = A.in[9]; const float* b_im = A.in[10]; const float* c_re = A.in[11]; const float* c_im = A.in[12];
    {
        bf16* KT = (bf16*)(ws + WS_KTAB); bf16* BM_ = (bf16*)(ws + WS_BMAT); bf16* CM = (bf16*)(ws + WS_CMAT);
        LAS f32x2* Wl = (LAS f32x2*)(F.lds + 73728);
        LAS f32x2* El = Wl + 512;
        LAS f32x2* Cl = El + 512;
        LAS f32x2* Bl = Cl + 1024;
        for (int item = idx; item < NG * 8; item += cnt) {
            const int g = item >> 3, blk = item & 7;
            __syncthreads();
            { const int dl = F.tid >> 6, pp = F.tid & 63; const SsmP q = ssm_param(a_re, a_im, log_dt, g, pp); float pre, pim; ssm_pow(q, 8 * blk + dl, pre, pim);
              Wl[F.tid] = (f32x2){pre * q.cre - pim * q.cim, pre * q.cim + pim * q.cre};
              El[F.tid] = (f32x2){pre * q.are - pim * q.aim, pre * q.aim + pim * q.are};
#pragma unroll
              for (int k = 0; k < 2; ++k) { const int i = F.tid + 512 * k; Cl[i] = (f32x2){c_re[(size_t)g * 1024 + i], c_im[(size_t)g * 1024 + i]}; Bl[i] = (f32x2){b_re[(size_t)g * 1024 + i], b_im[(size_t)g * 1024 + i]}; } }
            __syncthreads();
            {
                const int dl = F.tid >> 6, c = (F.tid >> 2) & 15, cq = F.tid & 3;
                float acc[4] = {0.f, 0.f, 0.f, 0.f};
#pragma unroll 8
                for (int pp = 0; pp < NS; ++pp) { const f32x2 w = Wl[dl * 64 + pp], cc = Cl[c * 64 + pp];
                    const float xr = cc.x * w.x - cc.y * w.y, xi = cc.x * w.y + cc.y * w.x;
#pragma unroll
                    for (int j = 0; j < 4; ++j) { const f32x2 b = Bl[pp * 16 + 4 * cq + j]; acc[j] += xr * b.x - xi * b.y; } }
                const int dd = 8 * blk + dl + 1;
                *(u32x2*)(KT + (((size_t)g * 65 + dd) * GC + c) * GC + 4 * cq) = (u32x2){cvtpk(acc[0], acc[1]), cvtpk(acc[2], acc[3])};
                if (blk == 0 && F.tid < 64) *(u32x2*)(KT + ((size_t)g * 65) * GC * GC + 4 * F.tid) = (u32x2){0u, 0u};
            }
            {
                const int dl = F.tid >> 6, pp = F.tid & 63, s2 = 63 - (8 * blk + dl); const f32x2 w = Wl[F.tid];
                float vr[GC], vi[GC];
#pragma unroll
                for (int cc = 0; cc < GC; ++cc) { const f32x2 b = Bl[pp * 16 + cc]; vr[cc] = w.x * b.x - w.y * b.y; vi[cc] = w.x * b.y + w.y * b.x; }
                u32x4* d0 = (u32x4*)(BM_ + ((size_t)g * 128 + pp) * 1024 + s2 * 16); u32x4* d1 = (u32x4*)(BM_ + ((size_t)g * 128 + 64 + pp) * 1024 + s2 * 16);
                d0[0] = (u32x4){cvtpk(vr[0], vr[1]), cvtpk(vr[2], vr[3]), cvtpk(vr[4], vr[5]), cvtpk(vr[6], vr[7])};
                d0[1] = (u32x4){cvtpk(vr[8], vr[9]), cvtpk(vr[10], vr[11]), cvtpk(vr[12], vr[13]), cvtpk(vr[14], vr[15])};
                d1[0] = (u32x4){cvtpk(vi[0], vi[1]), cvtpk(vi[2], vi[3]), cvtpk(vi[4], vi[5]), cvtpk(vi[6], vi[7])};
                d1[1] = (u32x4){cvtpk(vi[8], vi[9]), cvtpk(vi[10], vi[11]), cvtpk(vi[12], vi[13]), cvtpk(vi[14], vi[15])};
            }
#pragma unroll
            for (int k = 0; k < 2; ++k) {
                const int i = F.tid + 512 * k; const int pb = i & 7, c = (i >> 3) & 15, dl = i >> 7, tt = 8 * blk + dl;
                float vr[8], vi[8];
#pragma unroll
                for (int j = 0; j < 8; ++j) { const int pp = pb * 8 + j; const f32x2 e = El[dl * 64 + pp], cc = Cl[c * 64 + pp];
                    vr[j] = cc.x * e.x - cc.y * e.y; vi[j] = -(cc.x * e.y + cc.y * e.x); }
                bf16* row = CM + ((size_t)g * 1024 + tt * 16 + c) * 128;
                *(u32x4*)(row + pb * 8) = (u32x4){cvtpk(vr[0], vr[1]), cvtpk(vr[2], vr[3]), cvtpk(vr[4], vr[5]), cvtpk(vr[6], vr[7])};
                *(u32x4*)(row + 64 + pb * 8) = (u32x4){cvtpk(vi[0], vi[1]), cvtpk(vi[2], vi[3]), cvtpk(vi[4], vi[5]), cvtpk(vi[6], vi[7])};
            }
        }
        __syncthreads();
    }
}

typedef const f32x4 (&AccRef)[2][2][4][2];
typedef f32x4 (&AccMut)[2][2][4][2];
__device__ __forceinline__ void acc_zero(AccMut acc) {
#pragma unroll
    for (int a = 0; a < 2; ++a)
#pragma unroll
        for (int b = 0; b < 2; ++b)
#pragma unroll
            for (int m = 0; m < 4; ++m)
#pragma unroll
                for (int n = 0; n < 2; ++n) acc[a][b][m][n] = (f32x4){0.f, 0.f, 0.f, 0.f};
}
struct EpiInProj {
    static constexpr int PERM = 1;
    __device__ __forceinline__ void init(AccMut acc, const pg8::Unit&, int, int, int, int) const { acc_zero(acc); }
    bf16* Z; const float* bias; const f32x2* rope; bf16* U2;
    __device__ __forceinline__ void operator()(AccRef acc, const pg8::Unit& u, int wr, int wc, int fr, int fq) const {
        const int colt = u.pn * 256;
        if (colt < ZV) {
            const float sc = (colt < ZK) ? 0.125f * 1.4426950408889634f : 1.0f;
            const int a = 4 * (wc & 1) + fq, d0 = 4 * a;
#pragma unroll
            for (int ai = 0; ai < 2; ++ai)
#pragma unroll
                for (int m = 0; m < 4; ++m) {
                    const int row = u.pm * 256 + ai * 128 + wr * 64 + m * 16 + fr;
                    int pos = row < NTOK ? NMETA + (row & (SEQ - 1)) : row - NTOK; pos = pos < NPOS ? pos : NPOS - 1;
                    const f32x4* rp = (const f32x4*)(rope + (size_t)pos * 32 + d0); const f32x4 r0 = rp[0], r1 = rp[1];
                    const float cs[4] = {r0.x, r0.z, r1.x, r1.z}, sn[4] = {r0.y, r0.w, r1.y, r1.w};
#pragma unroll
                    for (int bj = 0; bj < 2; ++bj) {
                        const int hcol = colt + bj * 128 + (wc >> 1) * 64;
                        const f32x4 b1 = *(const f32x4*)(bias + hcol + d0), b2 = *(const f32x4*)(bias + hcol + 32 + d0);
                        const f32x4 t1 = acc[ai][bj][m][0] + b1, t2 = acc[ai][bj][m][1] + b2;
                        float o1[4], o2[4];
#pragma unroll
                        for (int j = 0; j < 4; ++j) { o1[j] = (t1[j] * cs[j] - t2[j] * sn[j]) * sc; o2[j] = (t2[j] * cs[j] + t1[j] * sn[j]) * sc; }
                        bf16* zp = Z + (size_t)row * INW + hcol + d0;
                        *(u32x2*)zp = (u32x2){cvtpk(o1[0], o1[1]), cvtpk(o1[2], o1[3])};
                        *(u32x2*)(zp + 32) = (u32x2){cvtpk(o2[0], o2[1]), cvtpk(o2[2], o2[3])};
                    }
                }
        } else {
            const int col0 = colt + wc * 32 + 8 * fq;
#pragma unroll
            for (int bj = 0; bj < 2; ++bj) {
                const f32x4 b0 = *(const f32x4*)(bias + col0 + bj * 128), b1 = *(const f32x4*)(bias + col0 + bj * 128 + 4);
#pragma unroll
                for (int ai = 0; ai < 2; ++ai)
#pragma unroll
                    for (int m = 0; m < 4; ++m) {
                        const int row = u.pm * 256 + ai * 128 + wr * 64 + m * 16 + fr;
                        const f32x4 v0 = acc[ai][bj][m][0] + b0, v1 = acc[ai][bj][m][1] + b1;
                        const u32x4 o = (u32x4){cvtpk(v0[0], v0[1]), cvtpk(v0[2], v0[3]), cvtpk(v1[0], v1[1]), cvtpk(v1[2], v1[3])};
                        const int cc = col0 + bj * 128;
                        if (cc < ZU) *(u32x4*)(Z + (size_t)row * INW + cc) = o;
                        else { const int cu = cc - ZU, gg = cu >> 4;
                            const int bb = row < NTOK ? (row >> 13) : 2, tt = row < NTOK ? (row & (SEQ - 1)) : (row - NTOK);
                            if (row < NTOK + 256) *(u32x4*)(U2 + (((size_t)bb * NG + gg) * SEQ + tt) * GC + (cu & 8)) = o; }
                    }
            }
        }
    }
};
struct EpiGlu {
    static constexpr int PERM = 1;
    const bf16* YS; bf16* YG; const float* bias;
    __device__ __forceinline__ void init(AccMut acc, const pg8::Unit& u, int, int wc, int, int fq) const {
        const int col0 = u.pn * 256 + wc * 32 + 8 * fq;
#pragma unroll
        for (int bj = 0; bj < 2; ++bj) {
            const f32x4 b0 = *(const f32x4*)(bias + col0 + bj * 128), b1 = *(const f32x4*)(bias + col0 + bj * 128 + 4);
#pragma unroll
            for (int ai = 0; ai < 2; ++ai)
#pragma unroll
                for (int m = 0; m < 4; ++m) { acc[ai][bj][m][0] = b0; acc[ai][bj][m][1] = b1; }
        }
    }
    __device__ __forceinline__ void operator()(AccRef acc, const pg8::Unit& u, int wr, int wc, int fr, int fq) const {
        const int col0 = u.pn * 256 + wc * 32 + 8 * fq;
#pragma unroll
        for (int bj = 0; bj < 2; ++bj)
#pragma unroll
            for (int ai = 0; ai < 2; ++ai)
#pragma unroll
                for (int m = 0; m < 4; ++m) {
                    const unsigned off = (unsigned)((u.pm * 256 + ai * 128 + wr * 64 + m * 16 + fr) * SW + col0 + bj * 128) * 2u;
                    const u32x4 y = *(const u32x4*)((const char*)YS + off);
                    const f32x4 t0 = acc[ai][bj][m][0] * -1.4426950408889634f, t1 = acc[ai][bj][m][1] * -1.4426950408889634f;
                    const f32x4 d0 = (f32x4){fast_exp2(t0[0]), fast_exp2(t0[1]), fast_exp2(t0[2]), fast_exp2(t0[3])} + 1.0f, d1 = (f32x4){fast_exp2(t1[0]), fast_exp2(t1[1]), fast_exp2(t1[2]), fast_exp2(t1[3])} + 1.0f;
                    const f32x4 o0 = (f32x4){bflo(y.x), bfhi(y.x), bflo(y.y), bfhi(y.y)} * (f32x4){fast_rcp(d0[0]), fast_rcp(d0[1]), fast_rcp(d0[2]), fast_rcp(d0[3])};
                    const f32x4 o1 = (f32x4){bflo(y.z), bfhi(y.z), bflo(y.w), bfhi(y.w)} * (f32x4){fast_rcp(d1[0]), fast_rcp(d1[1]), fast_rcp(d1[2]), fast_rcp(d1[3])};
                    *(u32x4*)((char*)YG + off) = (u32x4){cvtpk(o0[0], o0[1]), cvtpk(o0[2], o0[3]), cvtpk(o1[0], o1[1]), cvtpk(o1[2], o1[3])};
                }
    }
};
struct EpiOutProj {
    static constexpr int PERM = 1;
    const bf16* XN; const float* rsi; const float* gmix; bf16* H1; const float* bias;
    __device__ __forceinline__ void init(AccMut acc, const pg8::Unit& u, int wr, int wc, int fr, int fq) const {
        const int col0 = u.pn * 256 + wc * 32 + 8 * fq;
        float ri[2][4];
#pragma unroll
        for (int ai = 0; ai < 2; ++ai)
#pragma unroll
            for (int m = 0; m < 4; ++m) ri[ai][m] = rsi[u.pm * 256 + ai * 128 + wr * 64 + m * 16 + fr];
#pragma unroll
        for (int bj = 0; bj < 2; ++bj) {
            const f32x4 b0 = *(const f32x4*)(bias + col0 + bj * 128), b1 = *(const f32x4*)(bias + col0 + bj * 128 + 4);
            const f32x4 g0 = *(const f32x4*)(gmix + col0 + bj * 128), g1 = *(const f32x4*)(gmix + col0 + bj * 128 + 4);
            const f32x4 i0 = (f32x4){fast_rcp(g0[0]), fast_rcp(g0[1]), fast_rcp(g0[2]), fast_rcp(g0[3])}, i1 = (f32x4){fast_rcp(g1[0]), fast_rcp(g1[1]), fast_rcp(g1[2]), fast_rcp(g1[3])};
#pragma unroll
            for (int ai = 0; ai < 2; ++ai)
#pragma unroll
                for (int m = 0; m < 4; ++m) {
                    const unsigned off = (unsigned)((u.pm * 256 + ai * 128 + wr * 64 + m * 16 + fr) * DM + col0 + bj * 128) * 2u;
                    const u32x4 xn = *(const u32x4*)((const char*)XN + off);
                    acc[ai][bj][m][0] = (f32x4){bflo(xn.x), bfhi(xn.x), bflo(xn.y), bfhi(xn.y)} * i0 * ri[ai][m] + b0;
                    acc[ai][bj][m][1] = (f32x4){bflo(xn.z), bfhi(xn.z), bflo(xn.w), bfhi(xn.w)} * i1 * ri[ai][m] + b1;
                }
        }
    }
    __device__ __forceinline__ void operator()(AccRef acc, const pg8::Unit& u, int wr, int wc, int fr, int fq) const {
        const int col0 = u.pn * 256 + wc * 32 + 8 * fq;
#pragma unroll
        for (int bj = 0; bj < 2; ++bj)
#pragma unroll
            for (int ai = 0; ai < 2; ++ai)
#pragma unroll
                for (int m = 0; m < 4; ++m) {
                    const unsigned off = (unsigned)((u.pm * 256 + ai * 128 + wr * 64 + m * 16 + fr) * DM + col0 + bj * 128) * 2u;
                    const f32x4 v0 = acc[ai][bj][m][0], v1 = acc[ai][bj][m][1];
                    *(u32x4*)((char*)H1 + off) = (u32x4){cvtpk(v0[0], v0[1]), cvtpk(v0[2], v0[3]), cvtpk(v1[0], v1[1]), cvtpk(v1[2], v1[3])};
                }
    }
};
struct EpiMoe1 {
    static constexpr int PERM = 3;
    unsigned char* ACT; const float* b1; const LAS unsigned* tab; const LAS unsigned short* ids; const LAS unsigned char* lds_bias;
    __device__ __forceinline__ void init(AccMut acc, const pg8::Unit& u, int  , int wc, int  , int fq) const {
        const int e = __builtin_amdgcn_readfirstlane((int)tab[u.pm]) & 31;
        const __amdgpu_buffer_rsrc_t brs = __builtin_amdgcn_make_buffer_rsrc((void*)b1, 0, 0x7ffffff0, 0x00020000); const int bso = (e * 4096 + u.pn * 256 + wc * 64) * 4, bvo = 64 * fq;
        const LAS float* bl = (const LAS float*)(lds_bias) + (u.ord < BIAS_UNITS ? u.ord : 0) * 256 + wc * 64 + 16 * fq;
        const bool bl_ok = u.ord < BIAS_UNITS;
        f32x4 bv[4];
#pragma unroll
        for (int q = 0; q < 4; ++q) bv[q] = bl_ok ? *(const LAS f32x4*)(bl + 4 * q) : __builtin_bit_cast(f32x4, __builtin_amdgcn_raw_buffer_load_b128(brs, bvo + 16 * q, bso, 0));
#pragma unroll
        for (int bj = 0; bj < 2; ++bj) { const f32x4 bg = {bv[2 * bj][0], bv[2 * bj][2], bv[2 * bj + 1][0], bv[2 * bj + 1][2]}, bu = {bv[2 * bj][1], bv[2 * bj][3], bv[2 * bj + 1][1], bv[2 * bj + 1][3]};
#pragma unroll
            for (int ai = 0; ai < 2; ++ai)
#pragma unroll
                for (int m = 0; m < 4; ++m) { acc[ai][bj][m][0] = bg; acc[ai][bj][m][1] = bu; } }
    }
    __device__ __forceinline__ void operator()(AccRef acc, const pg8::Unit& u, int wr, int wc, int fr, int fq) const {
        const unsigned te = tab[u.pm]; const int e = te & 31u, nrows = (te >> 5) & 511u;
        const LAS unsigned short* id = ids + (u.ord % IDS_UNITS) * 256;
        const int col0 = u.pn * 256 + wc * 64 + 16 * fq;
        const f32x4 c7 = {7.0f, 7.0f, 7.0f, 7.0f}, cm7 = {-7.0f, -7.0f, -7.0f, -7.0f}, c1 = {1.0f, 1.0f, 1.0f, 1.0f}, c8 = {A8_SCALE, A8_SCALE, A8_SCALE, A8_SCALE};
#pragma unroll
        for (int ai = 0; ai < 2; ++ai)
#pragma unroll
            for (int m = 0; m < 4; ++m) {
                const int r = ai * 128 + wr * 64 + m * 16 + fr;
                if (r < nrows) {
                    unsigned w[2];
#pragma unroll
                    for (int bj = 0; bj < 2; ++bj) {
                        const f32x4 g = __builtin_elementwise_min(acc[ai][bj][m][0], c7), up = __builtin_elementwise_min(__builtin_elementwise_max(acc[ai][bj][m][1], cm7), c7);
                        const f32x4 t = g * (-1.702f * 1.4426950408889634f);
                        const f32x4 d = c1 + (f32x4){fast_exp2(t[0]), fast_exp2(t[1]), fast_exp2(t[2]), fast_exp2(t[3])};
                        const f32x4 o = (g * (f32x4){fast_rcp(d[0]), fast_rcp(d[1]), fast_rcp(d[2]), fast_rcp(d[3])}) * (up * c8 + c8);
                        w[bj] = cvt4_fp8(o[0], o[1], o[2], o[3]);
                    }
                    *(u32x2*)(ACT + (unsigned)((unsigned)id[r] * (unsigned)DFF + (unsigned)(col0 >> 1))) = (u32x2){w[0], w[1]};
                }
            }
    }
};
struct EpiMoe2 {
    static constexpr int PERM = 2;
    unsigned char* Y4; const float* b2; const float* gate; const LAS unsigned* tab; const LAS unsigned short* ids; const LAS unsigned char* lds_bias;
    __device__ __forceinline__ void init(AccMut acc, const pg8::Unit& u, int  , int wc, int  , int fq) const {
        const int e = __builtin_amdgcn_readfirstlane((int)tab[u.pm]) & 31;
        const __amdgpu_buffer_rsrc_t brs = __builtin_amdgcn_make_buffer_rsrc((void*)b2, 0, 0x7ffffff0, 0x00020000); const int bso = (e * DM + u.pn * 256 + wc * 64) * 4, bvo = 64 * fq;
        const LAS float* bl = (const LAS float*)(lds_bias) + (u.ord < BIAS_UNITS ? u.ord : 0) * 256 + wc * 64 + 16 * fq;
        const bool bl_ok = u.ord < BIAS_UNITS;
#pragma unroll
        for (int bj = 0; bj < 2; ++bj)
#pragma unroll
            for (int n = 0; n < 2; ++n) { const f32x4 bb = bl_ok ? *(const LAS f32x4*)(bl + bj * 8 + n * 4) : __builtin_bit_cast(f32x4, __builtin_amdgcn_raw_buffer_load_b128(brs, bvo + 32 * bj + 16 * n, bso, 0));
#pragma unroll
                for (int ai = 0; ai < 2; ++ai)
#pragma unroll
                    for (int m = 0; m < 4; ++m) acc[ai][bj][m][n] = bb; }
    }
    __device__ __forceinline__ void operator()(AccRef acc, const pg8::Unit& u, int wr, int wc, int fr, int fq) const {
        const unsigned te = tab[u.pm]; const int e = te & 31u, nrows = (te >> 5) & 511u;
        const LAS unsigned short* id = ids + (u.ord % IDS_UNITS) * 256;
        const int col0 = u.pn * 256 + wc * 64 + 16 * fq;
#pragma unroll
        for (int ai = 0; ai < 2; ++ai)
#pragma unroll
            for (int m = 0; m < 4; ++m) {
                const int r = ai * 128 + wr * 64 + m * 16 + fr;
                if (r < nrows) {
                    const unsigned pid = id[r]; const float gt = gate[pid] * Y8_SCALE;
                    unsigned w[4];
#pragma unroll
                    for (int bj = 0; bj < 2; ++bj)
#pragma unroll
                        for (int n = 0; n < 2; ++n) { const f32x4 v = acc[ai][bj][m][n] * gt; w[bj * 2 + n] = cvt4_fp8(v[0], v[1], v[2], v[3]); }
                    *(u32x4*)(Y4 + (unsigned)(pid * (unsigned)DM + (unsigned)col0)) = (u32x4){w[0], w[1], w[2], w[3]};
                }
            }
    }
};

constexpr int AT_KSTR = 72;
constexpr int AT_VSTR = 72;
constexpr int AT_NKEY = 224;
constexpr int AT_K_OFF = 0, AT_V_OFF = AT_NKEY * AT_KSTR * 2;
static_assert(AT_V_OFF + AT_NKEY * AT_VSTR * 2 <= RING_BYTES, "attention LDS");
struct AttnPre { u32x4 k[4], v[4]; };
__device__ __forceinline__ void attn_load(int tid, int unit, const bf16* Z, AttnPre& R) {
    const int b = unit >> 9, kvh = (unit >> 7) & 3, qb = unit & 127, t0 = qb * 64;
#pragma unroll
    for (int it = 0; it < 4; ++it) {
        const int ci = tid + 512 * it; const int j = ci >> 3, c = ci & 7;
        int row = -1;
        if (j < 32) { if (j < NMETA) row = NTOK + j; }
        else if (j < AT_NKEY) { const int tk = t0 - 128 + (j - 32); if (tk >= 0) row = b * SEQ + tk; }
        R.k[it] = (u32x4){0u, 0u, 0u, 0u}; R.v[it] = (u32x4){0u, 0u, 0u, 0u};
        if (row >= 0) { const bf16* zr = Z + (size_t)row * INW + kvh * 64 + 8 * c; R.k[it] = *(const u32x4*)(zr + ZK); R.v[it] = *(const u32x4*)(zr + ZV); }
    }
}
__device__ __forceinline__ void attn_unit(Frame& F, int unit, int next_unit, AttnPre& R, const bf16* Z, const float* sinks, bf16* YA) {
    const int tid = F.tid, lane = F.lane, w = F.wave;
    const int b = unit >> 9, kvh = (unit >> 7) & 3, qb = unit & 127, t0 = qb * 64;
    LAS bf16* Ks = (LAS bf16*)(F.lds + AT_K_OFF); LAS bf16* Vt = (LAS bf16*)(F.lds + AT_V_OFF);
    const int hq = kvh * 4 + (w >> 1), qh = w & 1, r32 = lane & 31, hi = lane >> 5;
    const int tq = t0 + 32 * qh + r32;
    bf16x8 qr[4];
    { const bf16* qp = Z + (size_t)(b * SEQ + tq) * INW + ZQ + hq * 64 + 8 * hi;
#pragma unroll
      for (int ks = 0; ks < 4; ++ks) qr[ks] = *(const bf16x8*)(qp + 16 * ks); }
#pragma unroll
    for (int it = 0; it < 4; ++it) {
        const int ci = tid + 512 * it; const int j = ci >> 3, c = ci & 7;
        if (j < AT_NKEY) {
            const u32x4 kv = R.k[it], vv = R.v[it];
            *(LAS u32x4*)(Ks + j * AT_KSTR + 8 * c) = kv;
            *(LAS u32x4*)(Vt + j * AT_VSTR + 8 * c) = vv;
        }
    }
    __syncthreads();
    if (next_unit >= 0) attn_load(tid, next_unit, Z, R);
    const float sink2 = sinks[hq] * 1.4426950408889634f;
    f32x16 S[6];
    float mx = sink2;
#pragma unroll
    for (int i = 0; i < 6; ++i) {
        const int jt = (i == 0) ? 0 : (qh + i);
        f32x16 s = {};
#pragma unroll
        for (int ks = 0; ks < 4; ++ks) {
            const bf16x8 kf = *(const LAS bf16x8*)(Ks + (32 * jt + r32) * AT_KSTR + 16 * ks + 8 * hi);
            s = __builtin_amdgcn_mfma_f32_32x32x16_bf16(kf, qr[ks], s, 0, 0, 0);
        }
        if (i >= 2 && i <= 4 && t0 >= 128) {
#pragma unroll
            for (int r = 0; r < 16; ++r) mx = fmaxf(mx, s[r]);
        } else {
#pragma unroll
        for (int r = 0; r < 16; ++r) {
            const int kr = (r & 3) + 8 * (r >> 2) + 4 * hi;
            bool ok;
            if (i == 0) ok = kr < NMETA;
            else { const int tk = t0 - 128 + 32 * (jt - 1) + kr; const int df = tq - tk; ok = (tk >= 0) && (df >= 0) && (df < 128); }
            s[r] = ok ? s[r] : -INFINITY;
            mx = fmaxf(mx, s[r]);
        }
        }
        S[i] = s;
    }
    mx = fmaxf(mx, __shfl_xor(mx, 32));
    float sum = 0.f;
#pragma unroll
    for (int i = 0; i < 6; ++i)
#pragma unroll
        for (int r = 0; r < 16; ++r) { const float p = fast_exp2(S[i][r] - mx); S[i][r] = p; sum += p; }
    sum += __shfl_xor(sum, 32);
    const float inv = 1.0f / (sum + fast_exp2(sink2 - mx));
    f32x16 O[2] = {};
#pragma unroll
    for (int i = 0; i < 6; ++i) {
        const int jt = (i == 0) ? 0 : (qh + i);
#pragma unroll
        for (int s2 = 0; s2 < 2; ++s2) {
            bf16x8 pf;
            { const unsigned w0 = cvtpk(S[i][8 * s2 + 0] * inv, S[i][8 * s2 + 1] * inv), w1 = cvtpk(S[i][8 * s2 + 2] * inv, S[i][8 * s2 + 3] * inv),
                             w2 = cvtpk(S[i][8 * s2 + 4] * inv, S[i][8 * s2 + 5] * inv), w3 = cvtpk(S[i][8 * s2 + 6] * inv, S[i][8 * s2 + 7] * inv);
              pf = __builtin_bit_cast(bf16x8, (u32x4){w0, w1, w2, w3}); }
#pragma unroll
            for (int dh = 0; dh < 2; ++dh) {
                const LAS bf16* vp = Vt + (32 * jt + 16 * s2 + 4 * hi + ((lane & 15) >> 2)) * AT_VSTR + 32 * dh + 16 * ((lane >> 4) & 1) + 4 * (lane & 3);
                const s16x4 v0 = __builtin_bit_cast(s16x4, __builtin_amdgcn_ds_read_tr16_b64_v4i16((LAS v4i16_t*)vp)), v1 = __builtin_bit_cast(s16x4, __builtin_amdgcn_ds_read_tr16_b64_v4i16((LAS v4i16_t*)(vp + 8 * AT_VSTR)));
                const bf16x8 vf = (bf16x8){v0[0], v0[1], v0[2], v0[3], v1[0], v1[1], v1[2], v1[3]};
                O[dh] = __builtin_amdgcn_mfma_f32_32x32x16_bf16(pf, vf, O[dh], 0, 0, 0);
            }
        }
    }
    { const bool odd = (lane & 1) != 0;
#pragma unroll
      for (int dh = 0; dh < 2; ++dh)
#pragma unroll
        for (int k = 0; k < 8; ++k) {
            const float va = O[dh][2 * k], vb = O[dh][2 * k + 1];
            const float rcv = __shfl_xor(odd ? va : vb, 1);
            const int r = odd ? 2 * k + 1 : 2 * k, q = (r & 3) + 8 * (r >> 2) + 4 * hi;
            *(unsigned*)(YA + (size_t)(b * SEQ + t0 + 32 * qh + q) * AW + hq * 64 + 32 * dh + (r32 & ~1)) = odd ? cvtpk(rcv, vb) : cvtpk(va, rcv);
        } }
    __syncthreads();
}

constexpr int SL_STR = 68;
static_assert(128 * SL_STR * 4 + 1024 <= RING_BYTES, "sloc LDS");
__device__ __forceinline__ void sloc_unit(Frame& F, int unit, const bf16* U2, const bf16* BMAT, const unsigned char* ssmt, bf16* SPREV) {
    const int lane = F.lane, w = F.wave, ph = unit & 1, b = (unit >> 1) & 1, g = unit >> 2;
    const int l15 = lane & 15, kq = lane >> 4;
    LAS float* SL = (LAS float*)F.lds; LAS float* UM = SL + 128 * SL_STR;
    if (F.tid < 256) UM[F.tid] = bf2f(U2[(((size_t)2 * NG + g) * SEQ + (F.tid >> 4)) * GC + (F.tid & 15)]);
    {
        const bf16* up = U2 + (((size_t)b * NG + g) * SEQ + (w * 16 + l15) * CH + (kq >> 1)) * GC + 8 * (kq & 1);
        const bf16* bp = BMAT + ((size_t)g * 128 + 32 * ph + l15) * 1024 + 8 * kq;
        f32x4 acc[4] = {};
        bf16x8 ufA[4], bfA[4][4], ufB[4], bfB[4][4];
#define SL_LD(ufv, bfv, sp0) do { _Pragma("unroll") for (int j = 0; j < 4; ++j) { ufv[j] = *(const bf16x8*)(up + (size_t)(2 * ((sp0) + j)) * GC); \
            _Pragma("unroll") for (int ct = 0; ct < 4; ++ct) bfv[j][ct] = *(const bf16x8*)(bp + (size_t)((ct >> 1) * 64 + (ct & 1) * 16) * 1024 + ((sp0) + j) * 32); } } while (0)
#define SL_MM(ufv, bfv) do { _Pragma("unroll") for (int j = 0; j < 4; ++j) _Pragma("unroll") for (int ct = 0; ct < 4; ++ct) acc[ct] = __builtin_amdgcn_mfma_f32_16x16x32_bf16(bfv[j][ct], ufv[j], acc[ct], 0, 0, 0); } while (0)
        SL_LD(ufA, bfA, 0);
#pragma unroll
        for (int bb = 0; bb < 8; bb += 2) {
            SL_LD(ufB, bfB, 4 * (bb + 1)); __builtin_amdgcn_sched_barrier(0);
            SL_MM(ufA, bfA); __builtin_amdgcn_sched_barrier(0);
            if (bb + 2 < 8) { SL_LD(ufA, bfA, 4 * (bb + 2)); __builtin_amdgcn_sched_barrier(0); }
            SL_MM(ufB, bfB); __builtin_amdgcn_sched_barrier(0);
        }
#undef SL_LD
#undef SL_MM
#pragma unroll
        for (int ct = 0; ct < 4; ++ct) *(LAS f32x4*)(SL + (w * 16 + l15) * SL_STR + 16 * ct + 4 * kq) = acc[ct];
    }
    __syncthreads();
    if (w == 0 && lane < 32) {
        const int p = 32 * ph + lane, idx = g * NS + p;
        const f32x2 ab = ((const f32x2*)(ssmt + SSMT_ABAR))[idx]; const f32x2 a64 = ((const f32x2*)(ssmt + SSMT_A64))[idx]; const f32x2* bb = (const f32x2*)(ssmt + SSMT_BBAR) + (size_t)idx * GC;
        float sr = 0.f, si = 0.f;
        for (int s2 = 0; s2 < NMETA; ++s2) {
            float xr = 0.f, xi = 0.f;
#pragma unroll
            for (int c = 0; c < GC; ++c) { const float uv = UM[s2 * 16 + c]; xr += bb[c].x * uv; xi += bb[c].y * uv; }
            const float nr = ab.x * sr - ab.y * si + xr, ni = ab.x * si + ab.y * sr + xi; sr = nr; si = ni;
        }
        bf16* dst = SPREV + ((size_t)(b * NG + g) * NCH) * 128 + p;
#pragma unroll 8
        for (int k = 0; k < NCH; ++k) {
            dst[(size_t)k * 128] = (bf16)(cvtpk(sr, 0.f) & 0xffffu); dst[(size_t)k * 128 + 64] = (bf16)(cvtpk(si, 0.f) & 0xffffu);
            const float lr = SL[k * SL_STR + lane], li = SL[k * SL_STR + 32 + lane];
            const float nr = a64.x * sr - a64.y * si + lr, ni = a64.x * si + a64.y * sr + li; sr = nr; si = ni;
        }
    }
    __syncthreads();
}

constexpr int SO_KT_OFF = 0;
constexpr int SO_SP_OFF = 36864;
constexpr int SO_SP_STR = 136;
static_assert(SO_SP_OFF + 8 * 16 * SO_SP_STR * 2 <= RING_BYTES, "ssm-out LDS");
__device__ __forceinline__ float gelu_tanh(float x) { const float u = 0.7978845608028654f * (x + 0.044715f * x * x * x); return x * sigmoidf_fast(2.0f * u); }
__device__ __forceinline__ void ssm_out_preload(Frame& F, int unit, const bf16* U2, bf16x8 (&U)[32]) {
    const int lane = F.lane, w = F.wave; const int hh = unit & 1, b = (unit >> 1) & 1, g = unit >> 2;
    const int rt = 4 * hh + (w & 3), l15 = lane & 15, kq = lane >> 4;
    const bf16* up = U2 + (((size_t)b * NG + g) * SEQ + (rt * 16 + l15) * CH + (kq >> 1)) * GC + 8 * (kq & 1);
#pragma unroll
    for (int sp = 0; sp < 32; ++sp) U[sp] = *(const bf16x8*)(up + (size_t)(2 * sp) * GC);
}
__device__ __forceinline__ void ssm_out_unit(Frame& F, int unit, const bf16* U2, const bf16* KTAB, const bf16* CMAT, const bf16* SPREV, const float* dskip, bf16* YS, bf16x8 (&U)[32], bool reload) {
    const int tid = F.tid, lane = F.lane, w = F.wave;
    const int hh = unit & 1, b = (unit >> 1) & 1, g = unit >> 2;
    const int rt = 4 * hh + (w & 3), ts = w >> 2, l15 = lane & 15, kq = lane >> 4;
    const bf16* up = U2 + (((size_t)b * NG + g) * SEQ + (rt * 16 + l15) * CH + (kq >> 1)) * GC + 8 * (kq & 1);
    if (reload) {
#pragma unroll
        for (int sp = 0; sp < 32; ++sp) U[sp] = *(const bf16x8*)(up + (size_t)(2 * sp) * GC);
    }
    u32x4 ktp[5];
    { const u32x4* src = (const u32x4*)(KTAB + (size_t)g * 65 * 256);
#pragma unroll
      for (int k = 0; k < 5; ++k) { const int i = tid + 512 * k; const bool ld = (i >= 7 * 32) && (i < 72 * 32); const u32x4 v = src[ld ? i - 7 * 32 : 0]; ktp[k] = ld ? v : (u32x4){0u, 0u, 0u, 0u}; } }
    bf16x8 SF[4];
#pragma unroll
    for (int i = 0; i < 4; ++i) SF[i] = *(const bf16x8*)(SPREV + ((size_t)(b * NG + g) * NCH + rt * 16 + l15) * 128 + 32 * i + 8 * kq);
    const LAS bf16* KT = (const LAS bf16*)(F.lds + SO_KT_OFF);
    const bf16* cm = CMAT + ((size_t)g * 1024 + l15) * 128 + 8 * kq;
    const f32x4 dsk = *(const f32x4*)(dskip + g * GC + 4 * kq);
#define SO_T(tt_) (ts ? 16 + (tt_) : ((tt_) < 16 ? (tt_) : 32 + (tt_)))
#define SO_LOAD(cfv, uuv, tt_) do { const int t_ = SO_T((tt_) < 32 ? (tt_) : 31); _Pragma("unroll") for (int i = 0; i < 4; ++i) cfv[i] = *(const bf16x8*)(cm + (size_t)t_ * 16 * 128 + 32 * i); \
        uuv = *(const u32x2*)(U2 + (((size_t)b * NG + g) * SEQ + (rt * 16 + l15) * CH + t_) * GC + 4 * kq); } while (0)
    bf16x8 cfa[4], cfb[4]; u32x2 uua, uub;
    SO_LOAD(cfa, uua, 0); SO_LOAD(cfb, uub, 1);
    { LAS u32x4* dst = (LAS u32x4*)(F.lds + SO_KT_OFF);
#pragma unroll
      for (int k = 0; k < 5; ++k) { const int i = tid + 512 * k; if (i < 72 * 32) dst[i] = ktp[k]; } }
    __syncthreads();
#pragma unroll 2
    for (int tt = 0; tt < 32; ++tt) {
        const int t = SO_T(tt);
        bf16x8 cf[4]; u32x2 uu;
        if (tt & 1) { _Pragma("unroll") for (int i = 0; i < 4; ++i) cf[i] = cfb[i]; uu = uub; SO_LOAD(cfb, uub, tt + 2); }
        else        { _Pragma("unroll") for (int i = 0; i < 4; ++i) cf[i] = cfa[i]; uu = uua; SO_LOAD(cfa, uua, tt + 2); }
        f32x4 acc0 = {}, acc1 = {};
        acc0 = __builtin_amdgcn_mfma_f32_16x16x32_bf16(cf[0], SF[0], acc0, 0, 0, 0); acc1 = __builtin_amdgcn_mfma_f32_16x16x32_bf16(cf[1], SF[1], acc1, 0, 0, 0);
        acc0 = __builtin_amdgcn_mfma_f32_16x16x32_bf16(cf[2], SF[2], acc0, 0, 0, 0); acc1 = __builtin_amdgcn_mfma_f32_16x16x32_bf16(cf[3], SF[3], acc1, 0, 0, 0);
        const LAS bf16* kb = KT + ((t + 8 - (kq >> 1)) * 16 + l15) * 16 + 8 * (kq & 1);
#pragma unroll
        for (int g4 = 0; g4 < 8; ++g4) {
            if (8 * g4 <= t) {
                const bf16x8 k0 = *(const LAS bf16x8*)(kb - (4 * g4 + 0) * 512), k1 = *(const LAS bf16x8*)(kb - (4 * g4 + 1) * 512);
                const bf16x8 k2 = *(const LAS bf16x8*)(kb - (4 * g4 + 2) * 512), k3 = *(const LAS bf16x8*)(kb - (4 * g4 + 3) * 512);
                acc0 = __builtin_amdgcn_mfma_f32_16x16x32_bf16(k0, U[4 * g4 + 0], acc0, 0, 0, 0); acc1 = __builtin_amdgcn_mfma_f32_16x16x32_bf16(k1, U[4 * g4 + 1], acc1, 0, 0, 0);
                acc0 = __builtin_amdgcn_mfma_f32_16x16x32_bf16(k2, U[4 * g4 + 2], acc0, 0, 0, 0); acc1 = __builtin_amdgcn_mfma_f32_16x16x32_bf16(k3, U[4 * g4 + 3], acc1, 0, 0, 0);
            }
        }
        const f32x4 acc = acc0 + acc1;
        const size_t row = (size_t)(b * SEQ + (rt * 16 + l15) * CH + t);
        const float y0 = gelu_tanh(acc[0] + dsk[0] * bflo(uu.x)), y1 = gelu_tanh(acc[1] + dsk[1] * bfhi(uu.x));
        const float y2 = gelu_tanh(acc[2] + dsk[2] * bflo(uu.y)), y3 = gelu_tanh(acc[3] + dsk[3] * bfhi(uu.y));
        *(u32x2*)(YS + row * SW + g * GC + 4 * kq) = (u32x2){cvtpk(y0, y1), cvtpk(y2, y3)};
    }
#undef SO_T
#undef SO_LOAD
    __syncthreads();
}

struct MixIn { u32x4 a0, a1, s0, s1; };
__device__ __forceinline__ MixIn mix_load(int m, int lane, const bf16* YA, const bf16* YG) {
    const u32x4* a = (const u32x4*)(YA + (size_t)m * AW) + lane; const u32x4* s = (const u32x4*)(YG + (size_t)m * SW) + lane;
    MixIn r; r.a0 = a[0]; r.a1 = a[64]; r.s0 = s[0]; r.s1 = s[64]; return r;
}
__device__ __forceinline__ void mixnorm_row(int m, int lane, const MixIn& in, const float* ga, const float* gs, bf16* MIX) {
    const u32x4 a0 = in.a0, a1 = in.a1, s0 = in.s0, s1 = in.s1;
    float va[16], vs[16];
    { const unsigned wa[8] = {a0.x, a0.y, a0.z, a0.w, a1.x, a1.y, a1.z, a1.w}, wsv[8] = {s0.x, s0.y, s0.z, s0.w, s1.x, s1.y, s1.z, s1.w};
#pragma unroll
      for (int i = 0; i < 8; ++i) { va[2 * i] = bflo(wa[i]); va[2 * i + 1] = bfhi(wa[i]); vs[2 * i] = bflo(wsv[i]); vs[2 * i + 1] = bfhi(wsv[i]); } }
    float qa = 0.f, qs = 0.f;
#pragma unroll
    for (int i = 0; i < 16; ++i) { qa += va[i] * va[i]; qs += vs[i] * vs[i]; }
    const float ra = 1.0f / sqrtf(wave_sum(qa) * (1.0f / AW) + NORM_EPS), rs = 1.0f / sqrtf(wave_sum(qs) * (1.0f / SW) + NORM_EPS);
#pragma unroll
    for (int h = 0; h < 2; ++h) {
        const int c0 = 8 * lane + 512 * h;
        const f32x4 g0 = *(const f32x4*)(ga + c0), g1 = *(const f32x4*)(ga + c0 + 4), k0 = *(const f32x4*)(gs + c0), k1 = *(const f32x4*)(gs + c0 + 4);
        const float* pa = va + 8 * h; const float* ps = vs + 8 * h;
        *(u32x4*)(MIX + (size_t)m * DM + c0) = (u32x4){cvtpk(pa[0] * ra * g0.x, pa[1] * ra * g0.y), cvtpk(pa[2] * ra * g0.z, pa[3] * ra * g0.w), cvtpk(pa[4] * ra * g1.x, pa[5] * ra * g1.y), cvtpk(pa[6] * ra * g1.z, pa[7] * ra * g1.w)};
        *(u32x4*)(MIX + (size_t)m * DM + AW + c0) = (u32x4){cvtpk(ps[0] * rs * k0.x, ps[1] * rs * k0.y), cvtpk(ps[2] * rs * k0.z, ps[3] * rs * k0.w), cvtpk(ps[4] * rs * k1.x, ps[5] * rs * k1.y), cvtpk(ps[6] * rs * k1.z, ps[7] * rs * k1.w)};
    }
}

constexpr int RT_NT_STR = 2056;
constexpr int RT_NT_OFF = 0, RT_PART_OFF = 16 * RT_NT_STR * 2  , RT_LOG_OFF = RT_PART_OFF + 16384, RT_SEL_OFF = RT_LOG_OFF + 8192, RT_HIST_OFF = RT_SEL_OFF + 1024, RT_BASE_OFF = RT_HIST_OFF + 128, RT_RANK_OFF = RT_BASE_OFF + 128;
static_assert(RT_RANK_OFF + 1024 <= RING_BYTES, "router LDS");
__device__ __forceinline__ void router_block(Frame& F, int rb, const bf16* H1, const float* gffn, const bf16* WRT, const float* brt, unsigned char* N2, float* GATE, int* LISTS, unsigned* counts) {
    const int lane = lane_id(), w = F.wave, tid = w * 64 + lane;
    LAS bf16* NT = (LAS bf16*)(F.lds + RT_NT_OFF); LAS float* PART = (LAS float*)(F.lds + RT_PART_OFF); LAS float* LOG = (LAS float*)(F.lds + RT_LOG_OFF);
    LAS int* SEL = (LAS int*)(F.lds + RT_SEL_OFF); LAS unsigned* HIST = (LAS unsigned*)(F.lds + RT_HIST_OFF); LAS unsigned* BASE = (LAS unsigned*)(F.lds + RT_BASE_OFF); LAS unsigned* RANK = (LAS unsigned*)(F.lds + RT_RANK_OFF);
    if (tid < 32) HIST[tid] = 0u;
    bf16x8 wb0[8], wb1[8];
    { const int l15 = lane & 15, kq = lane >> 4;
      const bf16* wp0 = WRT + (size_t)l15 * DM + 256 * w + 8 * kq; asm volatile("" : "+v"(wp0)); const bf16* wp1 = wp0 + (size_t)16 * DM; asm volatile("" : "+v"(wp1));
#pragma unroll
      for (int st = 0; st < 8; ++st) { wb0[st] = *(const bf16x8*)(wp0 + 32 * st); wb1[st] = *(const bf16x8*)(wp1 + 32 * st); } }
    u32x4 hn[4];
#pragma unroll
    for (int j = 0; j < 4; ++j) hn[j] = ((const u32x4*)(H1 + (size_t)(rb * 64 + 2 * w) * DM))[lane + 64 * j];
#pragma unroll 1
    for (int sb = 0; sb < 4; ++sb) {
        const int row0 = rb * 64 + sb * 16;
#pragma unroll 1
        for (int rr = 0; rr < 2; ++rr) {
            const int lr = 2 * w + rr, m = row0 + lr;
            u32x4 hc[4];
#pragma unroll
            for (int j = 0; j < 4; ++j) hc[j] = hn[j];
            { const int nidx = sb * 2 + rr + 1, nm = rb * 64 + ((nidx < 8 ? nidx : 7) >> 1) * 16 + 2 * w + ((nidx < 8 ? nidx : 7) & 1);
#pragma unroll
              for (int j = 0; j < 4; ++j) hn[j] = ((const u32x4*)(H1 + (size_t)nm * DM))[lane + 64 * j]; }
            float v[4][8]; float s = 0.f;
#pragma unroll
            for (int j = 0; j < 4; ++j) { const u32x4 h = hc[j];
                v[j][0] = bflo(h.x); v[j][1] = bfhi(h.x); v[j][2] = bflo(h.y); v[j][3] = bfhi(h.y); v[j][4] = bflo(h.z); v[j][5] = bfhi(h.z); v[j][6] = bflo(h.w); v[j][7] = bfhi(h.w);
#pragma unroll
                for (int i = 0; i < 8; ++i) s += v[j][i] * v[j][i]; }
            const float rstd = 1.0f / sqrtf(wave_sum(s) * (1.0f / DM) + NORM_EPS);
#pragma unroll
            for (int j = 0; j < 4; ++j) { const int c8 = 8 * (lane + 64 * j); const f32x4 g0 = *(const f32x4*)(gffn + c8), g1 = *(const f32x4*)(gffn + c8 + 4);
                float n[8];
                n[0] = v[j][0] * rstd * g0.x; n[1] = v[j][1] * rstd * g0.y; n[2] = v[j][2] * rstd * g0.z; n[3] = v[j][3] * rstd * g0.w;
                n[4] = v[j][4] * rstd * g1.x; n[5] = v[j][5] * rstd * g1.y; n[6] = v[j][6] * rstd * g1.z; n[7] = v[j][7] * rstd * g1.w;
                *(LAS u32x4*)(NT + lr * RT_NT_STR + c8) = (u32x4){cvtpk(n[0], n[1]), cvtpk(n[2], n[3]), cvtpk(n[4], n[5]), cvtpk(n[6], n[7])};
                *(u32x2*)(N2 + (size_t)m * DM + c8) = (u32x2){cvt4_fp8(n[0] * A8_SCALE, n[1] * A8_SCALE, n[2] * A8_SCALE, n[3] * A8_SCALE), cvt4_fp8(n[4] * A8_SCALE, n[5] * A8_SCALE, n[6] * A8_SCALE, n[7] * A8_SCALE)}; }
        }
        __syncthreads();
        {
            const int l15 = lane & 15, kq = lane >> 4; f32x4 a0 = {}, a1 = {};
#pragma unroll
            for (int st = 0; st < 8; ++st) {
                const int k = 256 * w + 32 * st + 8 * kq;
                const bf16x8 af = *(const LAS bf16x8*)(NT + l15 * RT_NT_STR + k);
                a0 = __builtin_amdgcn_mfma_f32_16x16x32_bf16(af, wb0[st], a0, 0, 0, 0); a1 = __builtin_amdgcn_mfma_f32_16x16x32_bf16(af, wb1[st], a1, 0, 0, 0);
            }
#pragma unroll
            for (int r = 0; r < 4; ++r) { PART[(w * 16 + 4 * kq + r) * 32 + l15] = a0[r]; PART[(w * 16 + 4 * kq + r) * 32 + 16 + l15] = a1[r]; }
        }
        __syncthreads();
        { const int r = tid >> 5, e = tid & 31; float s = brt[e];
#pragma unroll
          for (int ww = 0; ww < 8; ++ww) s += PART[(ww * 16 + r) * 32 + e];
          LOG[(sb * 16 + r) * 32 + e] = s; }
    }
    __syncthreads();
    if (tid < 64) {
        const int m = rb * 64 + tid; float tv[4]; int ti[4]; unsigned used = 0u;
        float lg[32];
#pragma unroll
        for (int e = 0; e < 32; ++e) lg[e] = LOG[tid * 32 + ((e + tid) & 31)];
#pragma unroll
        for (int k = 0; k < 4; ++k) { float best = -INFINITY; int bi = 0;
#pragma unroll
            for (int e = 0; e < 32; ++e) { const float v = lg[e]; const int ee = (e + tid) & 31;
                if (!((used >> ee) & 1u) && (v > best || (v == best && ee < bi))) { best = v; bi = ee; } }
            used |= 1u << bi; tv[k] = best; ti[k] = bi; }
        const float e1 = __expf(tv[1] - tv[0]), e2 = __expf(tv[2] - tv[0]), e3 = __expf(tv[3] - tv[0]); const float inv = 1.0f / (1.0f + e1 + e2 + e3);
        *(f32x4*)(GATE + (size_t)m * 4) = (f32x4){inv, e1 * inv, e2 * inv, e3 * inv};
#pragma unroll
        for (int k = 0; k < 4; ++k) SEL[tid * 4 + k] = ti[k];
    }
    __syncthreads();
    if (tid < 256) RANK[tid] = atomicAdd((unsigned*)&HIST[SEL[tid]], 1u);
    __syncthreads();
    if (tid < 32) BASE[tid] = HIST[tid] ? __hip_atomic_fetch_add(counts + CNT_STRIDE * tid, HIST[tid], RLX_AGENT) : 0u;
    __syncthreads();
    if (tid < 256) { const int e = SEL[tid]; LISTS[e * NTOK + BASE[e] + RANK[tid]] = rb * 256 + tid; }
    __syncthreads();
}

__device__ __forceinline__ int moe_setup(Frame& F, const unsigned* counts, const int* LISTS, int nN, pg8::StaticOrder& S, int e_lo, int e_hi, int G, int c, const float* bias, int bias_estride) {
    LAS unsigned* tab = (LAS unsigned*)(F.lds + TAB_OFF); LAS unsigned short* ids = (LAS unsigned short*)(F.lds + IDS_OFF);
    volatile LAS unsigned* MISC = F.MISC;
    __syncthreads();
    if (F.tid < 64) {
        const int ne = e_hi - e_lo, e = e_lo + F.tid; const int cnt = (F.tid < ne) ? (int)MISC[32 + e] : 0, nt = (cnt + 255) >> 8;
        int inc = nt;
#pragma unroll
        for (int d = 1; d < 32; d <<= 1) { const int o = __shfl_up(inc, d, 64); if (F.tid >= d) inc += o; }
        const int pre = inc - nt;
        for (int k = 0; k < nt; ++k) { const int r0 = k << 8, nr = cnt - r0 < 256 ? cnt - r0 : 256; tab[pre + k] = (unsigned)e | ((unsigned)nr << 5) | ((unsigned)r0 << 14); }
        if (F.tid == ne - 1) MISC[16] = (unsigned)inc; }
    __syncthreads();
    const int VM = __builtin_amdgcn_readfirstlane((int)MISC[16]);
    S.init(VM, nN, G, c);
    int nu = (VM * nN - c + G - 1) / G; nu = nu < 0 ? 0 : (nu > IDS_UNITS ? IDS_UNITS : nu);
    pg8::Unit u;
    int idv[IDS_UNITS]; float bsv[BIAS_UNITS];
#pragma unroll
    for (int i = 0; i < IDS_UNITS; ++i) if (i < nu) { S.next(i, u);
        const unsigned te = tab[u.pm]; const int e = te & 31u, nr = (te >> 5) & 511u, r0 = te >> 14;
        if (F.tid < 256) { const int r = F.tid < nr ? F.tid : 0; idv[i] = LISTS[e * NTOK + r0 + r]; }
        else if (i < BIAS_UNITS) bsv[i < BIAS_UNITS ? i : 0] = bias[(size_t)e * bias_estride + u.pn * 256 + (F.tid - 256)];
    }
#pragma unroll
    for (int i = 0; i < IDS_UNITS; ++i) if (i < nu) {
        if (F.tid < 256) ids[i * 256 + F.tid] = (unsigned short)idv[i];
        else if (i < BIAS_UNITS) ((LAS float*)(F.lds + BIAS_OFF))[i * 256 + (F.tid - 256)] = bsv[i < BIAS_UNITS ? i : 0];
    }
    __syncthreads();
    return VM;
}

struct FinIn { u32x4 h[4]; u32x2 y[4][4]; };
__device__ __forceinline__ void final_load(int m, int lane, const bf16* H1, const unsigned char* Y4, FinIn& r) {
#pragma unroll
    for (int j = 0; j < 4; ++j) r.h[j] = ((const u32x4*)(H1 + (size_t)m * DM))[lane + 64 * j];
#pragma unroll
    for (int k = 0; k < 4; ++k) { const u32x2* yr = (const u32x2*)(Y4 + ((size_t)m * 4 + k) * DM) + lane;
#pragma unroll
        for (int j = 0; j < 4; ++j) r.y[k][j] = yr[64 * j]; }
}
__device__ __forceinline__ void final_row(int m, int lane, const FinIn& in, const float* gfin, float* out) {
    float v[4][8];
#pragma unroll
    for (int j = 0; j < 4; ++j) { const u32x4 h = in.h[j];
        v[j][0] = bflo(h.x); v[j][1] = bfhi(h.x); v[j][2] = bflo(h.y); v[j][3] = bfhi(h.y); v[j][4] = bflo(h.z); v[j][5] = bfhi(h.z); v[j][6] = bflo(h.w); v[j][7] = bfhi(h.w); }
#pragma unroll
    for (int k = 0; k < 4; ++k) {
#pragma unroll
        for (int j = 0; j < 4; ++j) { const u32x2 y = in.y[k][j];
            const f32x2 a = __builtin_amdgcn_cvt_pk_f32_fp8((int)y.x, false), b2 = __builtin_amdgcn_cvt_pk_f32_fp8((int)y.x, true), c = __builtin_amdgcn_cvt_pk_f32_fp8((int)y.y, false), d = __builtin_amdgcn_cvt_pk_f32_fp8((int)y.y, true);
            v[j][0] += a.x * (1.0f / Y8_SCALE); v[j][1] += a.y * (1.0f / Y8_SCALE); v[j][2] += b2.x * (1.0f / Y8_SCALE); v[j][3] += b2.y * (1.0f / Y8_SCALE);
            v[j][4] += c.x * (1.0f / Y8_SCALE); v[j][5] += c.y * (1.0f / Y8_SCALE); v[j][6] += d.x * (1.0f / Y8_SCALE); v[j][7] += d.y * (1.0f / Y8_SCALE); } }
    float s = 0.f;
#pragma unroll
    for (int j = 0; j < 4; ++j)
#pragma unroll
        for (int i = 0; i < 8; ++i) s += v[j][i] * v[j][i];
    const float rstd = 1.0f / sqrtf(wave_sum(s) * (1.0f / DM) + NORM_EPS);
#pragma unroll
    for (int j = 0; j < 4; ++j) { const int c8 = 8 * (lane + 64 * j); const f32x4 g0 = *(const f32x4*)(gfin + c8), g1 = *(const f32x4*)(gfin + c8 + 4);
        f32x4* o = (f32x4*)(out + (size_t)m * DM + c8);
        o[0] = (f32x4){v[j][0] * rstd * g0.x, v[j][1] * rstd * g0.y, v[j][2] * rstd * g0.z, v[j][3] * rstd * g0.w};
        o[1] = (f32x4){v[j][4] * rstd * g1.x, v[j][5] * rstd * g1.y, v[j][6] * rstd * g1.z, v[j][7] * rstd * g1.w}; }
}

__global__ void __launch_bounds__(512, 2) fwd(Args args) {
    extern __shared__ __attribute__((aligned(16))) unsigned char lds_raw[];
    Frame F;
    F.lds = (LAS unsigned char*)lds_raw; F.MISC = (volatile LAS unsigned*)(F.lds + MISC_OFF);
    F.tid = threadIdx.x; F.lane = F.tid & 63; F.wave = __builtin_amdgcn_readfirstlane(F.tid >> 6);
    F.G = gridDim.x; { const int bx = blockIdx.x; F.vcu = (F.G % 8 == 0) ? (bx % 8) * (F.G / 8) + bx / 8 : bx; }
    F.ws = args.ws; F.ctl = (unsigned*)(args.ws + WS_CTL);
    if (F.tid < 64) F.MISC[F.tid] = 0u;
    __syncthreads();
    const int NH = (F.G > 4 * N_HELPERS) ? N_HELPERS : 0, GC0 = F.G - NH, bx = (int)blockIdx.x;
    (void)xcd_barrier_post(F.ctl + CW_BAR, F.MISC + 8, (unsigned)F.G);
#define BAR_A() grid_bar(F.ctl, F.MISC, 0, (unsigned)F.G)
#define REFRESH() do { int t_ = lane_id(); asm volatile("" : "+v"(t_)); F.lane = t_; F.tid = F.wave * 64 + t_; } while (0)
    unsigned char* ws = args.ws;
    const float* const w1f = args.in[23]; const float* const w2f = args.in[25];
    constexpr int CQ_HALF = CQ_W1 / 2;

    p0_prologue(F, args);
    REFRESH();
    convert_static(F, w1f, w2f, 0, CQ_HALF, F.vcu * 8 + F.wave, F.G * 8);
    BAR_A(); REFRESH();
    {
        const int gw = F.vcu * 8 + F.wave, NGW = F.G * 8;
        {
            pg8::ProbDense P{(const char*)(ws + WS_XN), (const char*)(ws + WS_WIN), DM, {}}; P.S.init(MROWS / 256, INW / 256, F.G, bx);
            EpiInProj E{(bf16*)(ws + WS_Z), args.in[4], (const f32x2*)(ws + WS_ROPE), (bf16*)(ws + WS_U2)};
            pg8::gemm_phase<pg8::ProbDense, EpiInProj, true>(F.lds, P, E, F.wave);
            REFRESH();
            { const int nwg = (MROWS / 256) * (INW / 256), r = nwg % F.G;
              if (r == 0) late_tables(F, args, bx, F.G); else if (bx >= r) late_tables(F, args, bx - r, F.G - r); }
        }
        BAR_A(); REFRESH();
        {
            const bf16* Z = (const bf16*)(ws + WS_Z);
            { AttnPre R; const int NU = NBATCH * NKVH * (SEQ / 64);
              if (F.vcu < NU) attn_load(F.tid, F.vcu, Z, R);
              for (int u = F.vcu; u < NU; u += F.G) attn_unit(F, u, (u + F.G < NU) ? u + F.G : -1, R, Z, args.in[5], (bf16*)(ws + WS_YA)); }
            for (int u = F.vcu; u < NG * NBATCH * 2; u += F.G) sloc_unit(F, u, (const bf16*)(ws + WS_U2), (const bf16*)(ws + WS_BMAT), ws + WS_SSMT, (bf16*)(ws + WS_SPREV));
        }
        bf16x8 soU[32]; const int so_u0 = F.vcu;
        asm volatile("s_waitcnt vmcnt(0)" ::: "memory");
        if (F.wave != 0) ssm_out_preload(F, so_u0 < NG * NBATCH * 2 ? so_u0 : 0, (const bf16*)(ws + WS_U2), soU);
        grid_bar<true>(F.ctl, F.MISC, 0, (unsigned)F.G); REFRESH();
        {
            for (int u = so_u0; u < NG * NBATCH * 2; u += F.G)
                ssm_out_unit(F, u, (const bf16*)(ws + WS_U2), (const bf16*)(ws + WS_KTAB), (const bf16*)(ws + WS_CMAT), (const bf16*)(ws + WS_SPREV), args.in[13], (bf16*)(ws + WS_YS), soU, (u != so_u0) || (F.wave == 0));
        }
        BAR_A(); REFRESH();
        {
            pg8::ProbDense P{(const char*)(ws + WS_YS), (const char*)(ws + WS_WGLU), SW, {}}; P.S.init(NTOK / 256, SW / 256, F.G, bx);
            EpiGlu E{(const bf16*)(ws + WS_YS), (bf16*)(ws + WS_YG), args.in[15]};
            pg8::gemm_phase<pg8::ProbDense, EpiGlu, true>(F.lds, P, E, F.wave);
        }
        BAR_A(); REFRESH();
        {
            const bf16* YA = (const bf16*)(ws + WS_YA); const bf16* YG = (const bf16*)(ws + WS_YG);
            if (gw < NTOK) {
                MixIn c0 = mix_load(gw, F.lane, YA, YG), c1 = mix_load(gw + NGW < NTOK ? gw + NGW : gw, F.lane, YA, YG);
#pragma unroll 1
                for (int m = gw; m < NTOK; m += 2 * NGW) {
                    const int mB = m + NGW, nA = m + 2 * NGW, nB = m + 3 * NGW;
                    const MixIn n0 = mix_load(nA < NTOK ? nA : m, F.lane, YA, YG), n1 = mix_load(nB < NTOK ? nB : m, F.lane, YA, YG);
                    mixnorm_row(m, F.lane, c0, args.in[16], args.in[17], (bf16*)(ws + WS_MIX));
                    if (mB < NTOK) mixnorm_row(mB, F.lane, c1, args.in[16], args.in[17], (bf16*)(ws + WS_MIX));
                    c0 = n0; c1 = n1;
                }
            }
        }
        BAR_A(); REFRESH();
        {
            pg8::ProbDense P{(const char*)(ws + WS_MIX), (const char*)(ws + WS_WOUT), DM, {}}; P.S.init(NTOK / 256, DM / 256, F.G, bx);
            EpiOutProj E{(const bf16*)(ws + WS_XN), (const float*)(ws + WS_RSI), args.in[2], (bf16*)(ws + WS_H1), args.in[19]};
            pg8::gemm_phase<pg8::ProbDense, EpiOutProj, true>(F.lds, P, E, F.wave);
        }
        BAR_A(); REFRESH();
        {
            for (int rb = F.vcu; rb < NTOK / 64; rb += F.G)
                router_block(F, rb, (const bf16*)(ws + WS_H1), args.in[20], (const bf16*)(ws + WS_WRT), args.in[22], ws + WS_N2, (float*)(ws + WS_GATE), (int*)(ws + WS_LISTS), F.ctl + CW_COUNTS);
        }
    }
    BAR_A(); REFRESH();

    __syncthreads();
    if (F.tid < 64) { const unsigned cnt = F.tid < 32 ? (F.ctl + CW_COUNTS)[CNT_STRIDE * F.tid] : 0u; if (F.tid < 32) F.MISC[32 + F.tid] = cnt;
        const float nt = (float)((cnt + 255u) >> 8); const float t0 = wave_sum(F.tid < 16 ? nt : 0.f), t1 = wave_sum(F.tid >= 16 ? nt : 0.f);
        if (F.tid == 0) { F.MISC[20] = (unsigned)(int)t0; F.MISC[21] = (unsigned)(int)t1; } }
    __syncthreads();
#pragma unroll
    for (int half = 0; half < 2; ++half) {
        const int units_h = 16 * __builtin_amdgcn_readfirstlane((int)F.MISC[20 + half]);
        int GC = GC0;
        if (NH > 0 && units_h > 0) { const int R = (units_h + GC0 - 1) / GC0; const int need = ((units_h + R - 1) / R + 7) & ~7; GC = need < GC0 ? need : GC0; if (GC < F.G / 2) GC = F.G / 2; }
        const bool helper = bx >= GC;
        if (!helper) {
            pg8::ProbMoe P{(const char*)(ws + WS_N2), (const char*)(ws + WS_W1T), DM, 2, (size_t)4096 * 2048, {}, (const LAS unsigned*)(F.lds + TAB_OFF), (const LAS unsigned short*)(F.lds + IDS_OFF)};
            moe_setup(F, F.ctl + CW_COUNTS, (const int*)(ws + WS_LISTS), 16, P.S, half * 16, half * 16 + 16, GC, bx, args.in[24], 4096);
            EpiMoe1 E{ws + WS_ACT, args.in[24], P.tab, P.ids, F.lds + BIAS_OFF};
            pg8::gemm_phase<pg8::ProbMoe, EpiMoe1, true>(F.lds, P, E, F.wave);
            REFRESH();
        }
        {
            const int lo = (half == 0) ? CQ_HALF : CQ_W1, hi = lo + CQ_HALF;
            const int s0 = (NH > 0) ? (CQ_HALF * CQ_STATIC_PCT / 100) / (NH * 16) * (NH * 16) : 0;
            if (helper && s0 > 0) convert_static(F, w1f, w2f, lo, lo + s0, (bx - GC) * 8 + F.wave, (F.G - GC) * 8);
            convert_queue(F, w1f, w2f, lo + s0, hi, F.ctl + CW_QUEUE + 512 * half, (bx + F.wave) & 7);
        }
        BAR_A(); REFRESH();
    }
    {
        pg8::ProbMoe P{(const char*)(ws + WS_ACT), (const char*)(ws + WS_W2T), DFF, 0, (size_t)2048 * 2048, {}, (const LAS unsigned*)(F.lds + TAB_OFF), (const LAS unsigned short*)(F.lds + IDS_OFF)};
        moe_setup(F, F.ctl + CW_COUNTS, (const int*)(ws + WS_LISTS), 8, P.S, 0, NEXP, F.G, bx, args.in[26], DM);
        EpiMoe2 E{ws + WS_Y4, args.in[26], (const float*)(ws + WS_GATE), P.tab, P.ids, F.lds + BIAS_OFF};
        pg8::gemm_phase<pg8::ProbMoe, EpiMoe2, true>(F.lds, P, E, F.wave);
    }
    BAR_A(); REFRESH();
    {
        const int gw = F.vcu * 8 + F.wave, NGW = F.G * 8;
        const bf16* H1p = (const bf16*)(ws + WS_H1);
        if (gw < NTOK) {
            FinIn cur; final_load(gw, F.lane, H1p, ws + WS_Y4, cur);
#pragma unroll 1
            for (int m = gw; m < NTOK; m += NGW) {
                FinIn nxt; final_load(m + NGW < NTOK ? m + NGW : m, F.lane, H1p, ws + WS_Y4, nxt);
                final_row(m, F.lane, cur, args.in[27], args.out);
                cur = nxt;
            }
        }
    }
}

extern "C" void kernel_launch(void* const* d_in, const int* in_sizes, int n_in, void* d_out, int out_size, void* d_ws, size_t ws_size, hipStream_t stream) {
    static int grid = 0;
    if (grid == 0) {
        if (n_in != 28 || out_size != NTOK * DM || ws_size < WS_END) { fprintf(stderr, "kernel_launch: unexpected shapes: n_in %d out %d ws %zu (need %zu)\n", n_in, out_size, ws_size, (size_t)WS_END); grid = -1; return; }
        int dev = 0, cus = 0, per_cu = 0;
        if (hipGetDevice(&dev) != hipSuccess || hipDeviceGetAttribute(&cus, hipDeviceAttributeMultiprocessorCount, dev) != hipSuccess) { grid = -1; return; }
        if (hipFuncSetAttribute((const void*)fwd, hipFuncAttributeMaxDynamicSharedMemorySize, LDS_BYTES) != hipSuccess) { fprintf(stderr, "kernel_launch: hipFuncSetAttribute failed\n"); grid = -1; return; }
        if (hipOccupancyMaxActiveBlocksPerMultiprocessor(&per_cu, (const void*)fwd, 512, LDS_BYTES) != hipSuccess || per_cu < 1) fprintf(stderr, "kernel_launch: occupancy query reports %d\n", per_cu);
        (void)hipGetLastError();
        grid = cus;
    }
    if (grid < 0) return;
    (void)hipMemsetAsync((char*)d_ws + WS_CTL, 0, CTL_ZERO_BYTES, stream);
    Args a{};
    for (int i = 0; i < 28; ++i) a.in[i] = (const float*)d_in[i];
    a.out = (float*)d_out; a.ws = (unsigned char*)d_ws;
    a.ph_lo = 0; a.ph_hi = N_PHASES; a.li = 0;
    hipLaunchKernelGGL(fwd, dim3(grid), dim3(512), LDS_BYTES, stream, a);
}
```
